# Optimizing an MI355X kernel written in HIP

```python
import math
import jax, jax.numpy as jnp
from jax import lax
import numpy as np

D_MODEL = 1024
BATCH = 4
SEQ = 8192
DEPTH = 1

D_SSM = 512
SSM_GROUP = 16
N_SSM_GROUPS = D_SSM // SSM_GROUP
SSM_STATE = 64
N_ATT_HEADS = 8
ATT_HEAD_DIM = 64
D_ATT = N_ATT_HEADS * ATT_HEAD_DIM
D_MIX = D_SSM + D_ATT
D_IN_PROJ = D_SSM + 3 * D_ATT
MOBA_BLOCK = 256
MOBA_TOPK = 3
Q_CHUNK = 32
PEER_HEADS = 8
PEER_KEY_DIM = 256
PEER_HALF = PEER_KEY_DIM // 2
PEER_N_KEYS = 128
PEER_N_EXPERTS = PEER_N_KEYS * PEER_N_KEYS
PEER_TOPK = 16
TOKEN_CHUNK = 128
LN_EPS = 1e-5
DN_ALPHA = (2.0 * DEPTH) ** 0.25
DN_BETA = (8.0 * DEPTH) ** -0.25
NEG = -1e30

kernel_name = "hymba_s5_moba_peer_deepnorm"


def _layernorm(x, g, b):
    xf = x.astype(jnp.float32)
    mu = jnp.mean(xf, axis=-1, keepdims=True)
    var = jnp.mean(jnp.square(xf - mu), axis=-1, keepdims=True)
    y = (xf - mu) * lax.rsqrt(var + LN_EPS) * g.astype(jnp.float32) + b.astype(jnp.float32)
    return y.astype(x.dtype)


def _diag_op(e1, e2):
    a1, b1 = e1
    a2, b2 = e2
    return a1 * a2, a2 * b1 + b2


def _s5(u, a_re, a_im, log_dt, b_re, b_im, c_re, c_im, d_skip, w_glu):
    bsz, L, _ = u.shape
    uf = u.astype(jnp.float32).reshape(bsz, L, N_SSM_GROUPS, SSM_GROUP)
    lam = lax.complex(a_re.astype(jnp.float32), a_im.astype(jnp.float32))
    dt = jnp.exp(log_dt.astype(jnp.float32))[:, None]
    lam_bar = jnp.exp(lam * dt)
    b_c = lax.complex(b_re.astype(jnp.float32), b_im.astype(jnp.float32))
    b_bar = ((lam_bar - 1.0) / lam)[:, :, None] * b_c
    bu = jnp.einsum('blgh,gph->blgp', uf.astype(jnp.complex64), b_bar)
    a = jnp.broadcast_to(lam_bar, (1, L) + lam_bar.shape)
    _, states = lax.associative_scan(_diag_op, (a, bu), axis=1)
    c_c = lax.complex(c_re.astype(jnp.float32), c_im.astype(jnp.float32))
    y = jnp.real(jnp.einsum('blgp,ghp->blgh', states, c_c)) + d_skip.astype(jnp.float32) * uf
    y = jax.nn.gelu(y.reshape(bsz, L, D_SSM))
    y = y * jax.nn.sigmoid(y @ w_glu.astype(jnp.float32))
    return y.astype(u.dtype)


def _moba(q, k, v):
    bsz, L, _ = q.shape
    n_blk = -(-L // MOBA_BLOCK)
    lp = n_blk * MOBA_BLOCK
    pad = lp - L

    def heads(t):
        t = jnp.pad(t, ((0, 0), (0, pad), (0, 0)))
        return t.reshape(bsz, lp, N_ATT_HEADS, ATT_HEAD_DIM).transpose(0, 2, 1, 3)

    qh, kh, vh = heads(q), heads(k), heads(v)
    kb = kh.reshape(bsz, N_ATT_HEADS, n_blk, MOBA_BLOCK, ATT_HEAD_DIM)
    vb = vh.reshape(bsz, N_ATT_HEADS, n_blk, MOBA_BLOCK, ATT_HEAD_DIM)
    kmean = jnp.mean(kb.astype(jnp.float32), axis=3)
    n_sel = min(MOBA_TOPK, n_blk)
    n_chunks = lp // Q_CHUNK
    qc = qh.reshape(bsz, N_ATT_HEADS, n_chunks, Q_CHUNK, ATT_HEAD_DIM).transpose(2, 0, 1, 3, 4)
    bi = jnp.arange(bsz)[:, None, None, None]
    hi = jnp.arange(N_ATT_HEADS)[None, :, None, None]
    blk_ids = jnp.arange(n_blk)
    scale = ATT_HEAD_DIM ** -0.5

    def chunk(args):
        c, qq = args
        start = c * Q_CHUNK
        own = start // MOBA_BLOCK
        q_pos = start + jnp.arange(Q_CHUNK)
        qf = qq.astype(jnp.float32)
        gate = jnp.einsum('bhqd,bhnd->bhqn', qf, kmean)
        gate = jnp.where(blk_ids < own, gate, NEG)
        _, sel = lax.top_k(gate, n_sel)
        valid = sel < own
        ks = kb[bi, hi, sel].astype(jnp.float32)
        vs = vb[bi, hi, sel].astype(jnp.float32)
        s_sel = jnp.einsum('bhqd,bhqskd->bhqsk', qf, ks) * scale
        s_sel = jnp.where(valid[..., None], s_sel, NEG)
        s_sel = s_sel.reshape(bsz, N_ATT_HEADS, Q_CHUNK, n_sel * MOBA_BLOCK)
        ko = lax.dynamic_index_in_dim(kb, own, axis=2, keepdims=False).astype(jnp.float32)
        vo = lax.dynamic_index_in_dim(vb, own, axis=2, keepdims=False).astype(jnp.float32)
        k_pos = own * MOBA_BLOCK + jnp.arange(MOBA_BLOCK)
        s_own = jnp.einsum('bhqd,bhkd->bhqk', qf, ko) * scale
        s_own = jnp.where(k_pos[None, :] <= q_pos[:, None], s_own, NEG)
        p = jax.nn.softmax(jnp.concatenate([s_sel, s_own], axis=-1), axis=-1)
        p_sel = p[..., :n_sel * MOBA_BLOCK].reshape(bsz, N_ATT_HEADS, Q_CHUNK, n_sel, MOBA_BLOCK)
        p_own = p[..., n_sel * MOBA_BLOCK:]
        o = jnp.einsum('bhqsk,bhqskd->bhqd', p_sel, vs) + jnp.einsum('bhqk,bhkd->bhqd', p_own, vo)
        return o.astype(qq.dtype)

    out = lax.map(chunk, (jnp.arange(n_chunks), qc))
    out = out.transpose(1, 2, 0, 3, 4).reshape(bsz, N_ATT_HEADS, lp, ATT_HEAD_DIM)[:, :, :L]
    return out.transpose(0, 2, 1, 3).reshape(bsz, L, D_ATT)


def _hybrid_mixer(h, w_in, a_re, a_im, log_dt, b_re, b_im, c_re, c_im, d_skip, w_glu, w_out):
    proj = h @ w_in
    u = proj[..., :D_SSM]
    q = proj[..., D_SSM:D_SSM + D_ATT]
    k = proj[..., D_SSM + D_ATT:D_SSM + 2 * D_ATT]
    v = proj[..., D_SSM + 2 * D_ATT:]
    y_ssm = _s5(u, a_re, a_im, log_dt, b_re, b_im, c_re, c_im, d_skip, w_glu)
    y_att = _moba(q, k, v)
    return jnp.concatenate([y_ssm, y_att], axis=-1) @ w_out


def _peer(h, w_q, sub_keys, expert_u, expert_v):
    bsz, L, d = h.shape
    n_tok = bsz * L
    xt = h.reshape(n_tok // TOKEN_CHUNK, TOKEN_CHUNK, d)

    def chunk(xc):
        q = (xc @ w_q).astype(jnp.float32).reshape(TOKEN_CHUNK, PEER_HEADS, 2, PEER_HALF)
        s = jnp.einsum('thcd,hcnd->thcn', q, sub_keys.astype(jnp.float32))
        s1, i1 = lax.top_k(s[:, :, 0], PEER_TOPK)
        s2, i2 = lax.top_k(s[:, :, 1], PEER_TOPK)
        cand = (s1[..., :, None] + s2[..., None, :]).reshape(TOKEN_CHUNK, PEER_HEADS, PEER_TOPK * PEER_TOPK)
        cidx = (i1[..., :, None] * PEER_N_KEYS + i2[..., None, :]).reshape(TOKEN_CHUNK, PEER_HEADS, PEER_TOPK * PEER_TOPK)
        top, pos = lax.top_k(cand, PEER_TOPK)
        eidx = jnp.take_along_axis(cidx, pos, axis=-1)
        g = jax.nn.softmax(top, axis=-1)
        u = expert_u[eidx].astype(jnp.float32)
        act = jax.nn.gelu(jnp.einsum('td,thkd->thk', xc.astype(jnp.float32), u))
        out = jnp.einsum('thk,thkd->td', g * act, expert_v[eidx].astype(jnp.float32))
        return out.astype(xc.dtype)

    return lax.map(chunk, xt).reshape(bsz, L, d)


def setup_inputs(seed: int = 0) -> dict:
    key = jax.random.key(seed)
    ks = jax.random.split(key, 20)
    f32 = jnp.float32
    G, P, H = N_SSM_GROUPS, SSM_STATE, SSM_GROUP
    x = jax.random.normal(ks[0], (BATCH, SEQ, D_MODEL), f32)
    w_in = jax.random.normal(ks[1], (DEPTH, D_MODEL, D_IN_PROJ), f32) * D_MODEL ** -0.5
    ssm_a_re = -0.5 + 0.01 * jax.random.normal(ks[2], (DEPTH, G, P), f32)
    ssm_a_im = jnp.pi * jnp.arange(P, dtype=f32)[None, None, :] + 0.01 * jax.random.normal(ks[3], (DEPTH, G, P), f32)
    ssm_log_dt = jax.random.uniform(ks[4], (DEPTH, G), f32, math.log(1e-3), math.log(1e-1))
    ssm_b_re = jax.random.normal(ks[5], (DEPTH, G, P, H), f32) * (2.0 * H) ** -0.5
    ssm_b_im = jax.random.normal(ks[6], (DEPTH, G, P, H), f32) * (2.0 * H) ** -0.5
    ssm_c_re = jax.random.normal(ks[7], (DEPTH, G, H, P), f32) * (2.0 * P) ** -0.5
    ssm_c_im = jax.random.normal(ks[8], (DEPTH, G, H, P), f32) * (2.0 * P) ** -0.5
    ssm_d = jax.random.normal(ks[9], (DEPTH, G, H), f32)
    ssm_w_glu = jax.random.normal(ks[10], (DEPTH, D_SSM, D_SSM), f32) * D_SSM ** -0.5
    w_out = jax.random.normal(ks[11], (DEPTH, D_MIX, D_MODEL), f32) * (D_MIX ** -0.5) * DN_BETA
    ln1_g = 1.0 + 0.02 * jax.random.normal(ks[12], (DEPTH, D_MODEL), f32)
    ln1_b = 0.02 * jax.random.normal(ks[13], (DEPTH, D_MODEL), f32)
    peer_w_q = jax.random.normal(ks[14], (DEPTH, D_MODEL, PEER_HEADS * PEER_KEY_DIM), f32) * D_MODEL ** -0.5
    peer_sub_keys = jax.random.normal(ks[15], (DEPTH, PEER_HEADS, 2, PEER_N_KEYS, PEER_HALF), f32) * PEER_HALF ** -0.5
    peer_u = jax.random.normal(ks[16], (DEPTH, PEER_N_EXPERTS, D_MODEL), f32) * D_MODEL ** -0.5
    peer_v = jax.random.normal(ks[17], (DEPTH, PEER_N_EXPERTS, D_MODEL), f32) * DN_BETA * PEER_HEADS ** -0.5
    ln2_g = 1.0 + 0.02 * jax.random.normal(ks[18], (DEPTH, D_MODEL), f32)
    ln2_b = 0.02 * jax.random.normal(ks[19], (DEPTH, D_MODEL), f32)
    return {"x": x, "w_in": w_in, "ssm_a_re": ssm_a_re, "ssm_a_im": ssm_a_im,
            "ssm_log_dt": ssm_log_dt, "ssm_b_re": ssm_b_re, "ssm_b_im": ssm_b_im,
            "ssm_c_re": ssm_c_re, "ssm_c_im": ssm_c_im, "ssm_d": ssm_d,
            "ssm_w_glu": ssm_w_glu, "w_out": w_out, "ln1_g": ln1_g, "ln1_b": ln1_b,
            "peer_w_q": peer_w_q, "peer_sub_keys": peer_sub_keys, "peer_u": peer_u,
            "peer_v": peer_v, "ln2_g": ln2_g, "ln2_b": ln2_b}


def reference(x, w_in, ssm_a_re, ssm_a_im, ssm_log_dt, ssm_b_re, ssm_b_im, ssm_c_re, ssm_c_im,
              ssm_d, ssm_w_glu, w_out, ln1_g, ln1_b, peer_w_q, peer_sub_keys, peer_u, peer_v,
              ln2_g, ln2_b):
    h = x
    for l in range(DEPTH):
        mix = _hybrid_mixer(h, w_in[l], ssm_a_re[l], ssm_a_im[l], ssm_log_dt[l], ssm_b_re[l],
                            ssm_b_im[l], ssm_c_re[l], ssm_c_im[l], ssm_d[l], ssm_w_glu[l], w_out[l])
        h = _layernorm(DN_ALPHA * h + mix, ln1_g[l], ln1_b[l])
        ffn = _peer(h, peer_w_q[l], peer_sub_keys[l], peer_u[l], peer_v[l])
        h = _layernorm(DN_ALPHA * h + ffn, ln2_g[l], ln2_b[l])
    return h
```

```cpp
#include <hip/hip_runtime.h>
#include <hip/hip_cooperative_groups.h>
#include <cstdio>
#include <cstdint>
namespace cg = cooperative_groups;

#ifndef MULTI_LAUNCH
#define MULTI_LAUNCH 1
#endif

#define DI __device__ __forceinline__
typedef unsigned short u16;
using bf16x8 = __attribute__((ext_vector_type(8))) short;
using f32x4  = __attribute__((ext_vector_type(4))) float;
using f32x16 = __attribute__((ext_vector_type(16))) float;
typedef _Float16 h2 __attribute__((ext_vector_type(2)));
typedef _Float16 h8 __attribute__((ext_vector_type(8)));

constexpr int NTOK = 32768, DM = 1024, SEQ = 8192;
constexpr float ALPHA = 1.189207115002721f;
constexpr size_t MB = 1u << 20;
constexpr size_t OFF_QB = 0, OFF_KB = 32 * MB, OFF_UH = 0, OFF_VH = 32 * MB;
constexpr size_t OFF_XB = 64 * MB, OFF_YB = 64 * MB, OFF_H1H = 64 * MB;
constexpr size_t OFF_OPART = 128 * MB, OFF_LSE = 256 * MB, OFF_Z1 = 128 * MB, OFF_QP = 128 * MB, OFF_EIDX = 128 * MB, OFF_G = 144 * MB;
constexpr size_t OFF_WY = 260 * MB, OFF_WST = 332 * MB, OFF_SLOC = 340 * MB, OFF_LIST = 348 * MB;
constexpr size_t OFF_H1B = 256 * MB, OFF_ST = 256 * MB;
constexpr size_t OFF_WINT = 384 * MB, OFF_WQT = 388 * MB, OFF_WOT = 392 * MB, OFF_WGT = 394 * MB, OFF_SKB = 394 * MB + 512 * 1024;
constexpr size_t OFF_KTAB = 395 * MB, OFF_KMEAN = 397 * MB, OFF_GCOUNT = 397 * MB + 256 * 1024;
constexpr size_t OFF_VT = 400 * MB, OFF_CAT = 400 * MB, OFF_UG = 464 * MB;
constexpr size_t WS_NEED = 500 * MB;
constexpr int UGLD = 1152;

struct Params {
  const float *x, *w_in, *a_re, *a_im, *log_dt, *b_re, *b_im, *c_re, *c_im, *dsk, *w_glu, *w_out, *ln1g, *ln1b, *w_q, *subk, *pu, *pv, *ln2g, *ln2b;
  float* out;
  char* ws;
};

DI u16 f2bf(float x) { unsigned u = __float_as_uint(x); u += 0x7fffu + ((u >> 16) & 1u); return (u16)(u >> 16); }
DI float bf2f(u16 b) { return __uint_as_float(((unsigned)b) << 16); }
DI unsigned pack2bf(float a, float b) { return (unsigned)f2bf(a) | ((unsigned)f2bf(b) << 16); }
DI float gelu_t(float x) { float u = 0.7978845608028654f * (x + 0.044715f * x * x * x); float e = __expf(2.f * u); float t = 1.f - 2.f / (1.f + e); return 0.5f * x * (1.f + t); }
DI float2 cmul(float2 a, float2 b) { return make_float2(a.x * b.x - a.y * b.y, a.x * b.y + a.y * b.x); }
DI float2 cexpf2(float re, float im) { float e = expf(re); float s, c; sincosf(im, &s, &c); return make_float2(e * c, e * s); }
DI float wave_sum(float v) { for (int o = 32; o > 0; o >>= 1) v += __shfl_xor(v, o); return v; }

template <class Epi>
DI void gemm_tile(const u16* __restrict__ Ag, long lda, const u16* __restrict__ Bg, long ldb, int ka0, int ka1, int kb0, int kb1, char* shm, Epi&& epi) {
  const int tid = threadIdx.x, wid = tid >> 6, lane = tid & 63, wr = wid >> 1, wc = wid & 1, fr = lane & 15, fq = lane >> 4;
  char* SA = shm; char* SB = shm + 8192;
  f32x4 acc[4][4];
#pragma unroll
  for (int m = 0; m < 4; ++m)
#pragma unroll
    for (int n = 0; n < 4; ++n) acc[m][n] = f32x4{0.f, 0.f, 0.f, 0.f};
  int kt = ka0, kend = ka1, seg = 0;
  while (true) {
    if (kt >= kend) { if (seg == 0) { seg = 1; kt = kb0; kend = kb1; continue; } break; }
#pragma unroll
    for (int i = 0; i < 2; ++i) {
      int b = tid * 16 + i * 4096, r = b >> 6, c = (b & 63) >> 1;
      __builtin_amdgcn_global_load_lds((const unsigned*)(Ag + (long)r * lda + kt * 32 + c), (__attribute__((address_space(3))) unsigned*)(SA + b), 16, 0, 0);
      __builtin_amdgcn_global_load_lds((const unsigned*)(Bg + (long)r * ldb + kt * 32 + c), (__attribute__((address_space(3))) unsigned*)(SB + b), 16, 0, 0);
    }
    asm volatile("s_waitcnt vmcnt(0)" ::: "memory");
    __syncthreads();
    bf16x8 At[4], Bt[4];
#pragma unroll
    for (int m = 0; m < 4; ++m) {
      At[m] = *reinterpret_cast<const bf16x8*>(SA + (wr * 64 + m * 16 + fr) * 64 + fq * 16);
      Bt[m] = *reinterpret_cast<const bf16x8*>(SB + (wc * 64 + m * 16 + fr) * 64 + fq * 16);
    }
#pragma unroll
    for (int m = 0; m < 4; ++m)
#pragma unroll
      for (int n = 0; n < 4; ++n) acc[m][n] = __builtin_amdgcn_mfma_f32_16x16x32_bf16(At[m], Bt[n], acc[m][n], 0, 0, 0);
    __syncthreads();
    ++kt;
  }
#pragma unroll
  for (int m = 0; m < 4; ++m)
#pragma unroll
    for (int n = 0; n < 4; ++n) epi(wr * 64 + m * 16 + fq * 4, wc * 64 + n * 16 + fr, acc[m][n]);
}

DI void transpose_bf16(const float* __restrict__ src, int K, int N, u16* __restrict__ dst) {
  const long total = (long)(K / 8) * N;
  for (long idx = (long)blockIdx.x * 256 + threadIdx.x; idx < total; idx += (long)gridDim.x * 256) {
    int n = (int)(idx % N), k8 = (int)(idx / N);
    unsigned w[4];
#pragma unroll
    for (int j = 0; j < 4; ++j) w[j] = pack2bf(src[(long)(k8 * 8 + 2 * j) * N + n], src[(long)(k8 * 8 + 2 * j + 1) * N + n]);
    *reinterpret_cast<uint4*>(dst + (long)n * K + k8 * 8) = make_uint4(w[0], w[1], w[2], w[3]);
  }
}
DI void cvt_bf16(const float* __restrict__ src, long n, u16* __restrict__ dst) {
  for (long idx = (long)blockIdx.x * 256 + threadIdx.x; idx < n / 8; idx += (long)gridDim.x * 256) {
    float4 a = reinterpret_cast<const float4*>(src)[idx * 2], b = reinterpret_cast<const float4*>(src)[idx * 2 + 1];
    reinterpret_cast<uint4*>(dst)[idx] = make_uint4(pack2bf(a.x, a.y), pack2bf(a.z, a.w), pack2bf(b.x, b.y), pack2bf(b.z, b.w));
  }
}
DI void cvt_f16(const float* __restrict__ src, long n, _Float16* __restrict__ dst) {
  for (long idx = (long)blockIdx.x * 256 + threadIdx.x; idx < n / 8; idx += (long)gridDim.x * 256) {
    float4 a = reinterpret_cast<const float4*>(src)[idx * 2], b = reinterpret_cast<const float4*>(src)[idx * 2 + 1];
    h8 o; o[0] = (_Float16)a.x; o[1] = (_Float16)a.y; o[2] = (_Float16)a.z; o[3] = (_Float16)a.w; o[4] = (_Float16)b.x; o[5] = (_Float16)b.y; o[6] = (_Float16)b.z; o[7] = (_Float16)b.w;
    reinterpret_cast<h8*>(dst)[idx] = o;
  }
}
DI float2 ssm_f(const Params& P, int g, int p, float dt) {
  float ar = P.a_re[g * 64 + p], ai = P.a_im[g * 64 + p];
  float2 lb = cexpf2(ar * dt, ai * dt);
  float nr = lb.x - 1.f, ni = lb.y, den = ar * ar + ai * ai;
  return make_float2((nr * ar + ni * ai) / den, (ni * ar - nr * ai) / den);
}

DI void phase0(const Params& P, char* smem) {
  char* ws = P.ws;
  cvt_bf16(P.x, (long)NTOK * DM, (u16*)(ws + OFF_XB));
  transpose_bf16(P.w_in, 1024, 2048, (u16*)(ws + OFF_WINT));
  transpose_bf16(P.w_glu, 512, 512, (u16*)(ws + OFF_WGT));
  transpose_bf16(P.w_out, 1024, 1024, (u16*)(ws + OFF_WOT));
  transpose_bf16(P.w_q, 1024, 2048, (u16*)(ws + OFF_WQT));
  cvt_bf16(P.subk, 8 * 2 * 128 * 128, (u16*)(ws + OFF_SKB));
  const long gtid = (long)blockIdx.x * 256 + threadIdx.x, gstride = (long)gridDim.x * 256;
  {
    u16* Wst = (u16*)(ws + OFF_WST);
    for (long idx = gtid; idx < 32L * 64 * 1024; idx += gstride) {
      int g = (int)(idx >> 16), p = (int)(idx >> 10) & 63, k = (int)idx & 1023, j = k >> 4, hp = k & 15;
      float dt = expf(P.log_dt[g]);
      float ar = P.a_re[g * 64 + p], ai = P.a_im[g * 64 + p];
      float d = (float)(63 - j);
      float2 E = cmul(cexpf2(ar * dt * d, ai * dt * d), ssm_f(P, g, p, dt));
      float2 Bv = make_float2(P.b_re[(g * 64 + p) * 16 + hp], P.b_im[(g * 64 + p) * 16 + hp]);
      float2 v = cmul(E, Bv);
      Wst[((long)g * 128 + 2 * p) * 1024 + k] = f2bf(v.x);
      Wst[((long)g * 128 + 2 * p + 1) * 1024 + k] = f2bf(v.y);
    }
  }
  {
    u16* Wy = (u16*)(ws + OFF_WY);
    for (long idx = gtid; idx < 32L * 1024 * 64; idx += gstride) {
      int g = (int)(idx >> 16), n = (int)(idx >> 6) & 1023, p = (int)idx & 63, i = n >> 4, h = n & 15;
      float dt = expf(P.log_dt[g]);
      float ar = P.a_re[g * 64 + p], ai = P.a_im[g * 64 + p];
      float d = (float)(i + 1);
      float2 z = cmul(make_float2(P.c_re[(g * 16 + h) * 64 + p], P.c_im[(g * 16 + h) * 64 + p]), cexpf2(ar * dt * d, ai * dt * d));
      *reinterpret_cast<unsigned*>(Wy + ((long)g * 1024 + n) * UGLD + 1024 + 2 * p) = pack2bf(z.x, -z.y);
    }
  }
  {
    float* Ktab = (float*)(ws + OFF_KTAB);
    float2* Es = (float2*)smem;
    for (int item = blockIdx.x; item < 32 * 64; item += gridDim.x) {
      int g = item >> 6, d = item & 63, tid = threadIdx.x;
      if (tid < 64) {
        float dt = expf(P.log_dt[g]);
        float ar = P.a_re[g * 64 + tid], ai = P.a_im[g * 64 + tid];
        Es[tid] = cmul(cexpf2(ar * dt * (float)d, ai * dt * (float)d), ssm_f(P, g, tid, dt));
      }
      __syncthreads();
      int h = tid >> 4, hp = tid & 15;
      float s = 0.f;
      for (int p = 0; p < 64; ++p) {
        float2 T = cmul(Es[p], make_float2(P.b_re[(g * 64 + p) * 16 + hp], P.b_im[(g * 64 + p) * 16 + hp]));
        s += P.c_re[(g * 16 + h) * 64 + p] * T.x - P.c_im[(g * 16 + h) * 64 + p] * T.y;
      }
      Ktab[((g * 64 + d) * 16 + h) * 16 + hp] = s;
      __syncthreads();
    }
  }
  {
    int* gcount = (int*)(ws + OFF_GCOUNT);
    for (long idx = gtid; idx < 1024; idx += gstride) gcount[idx] = 0;
  }
}

DI void phase1(const Params& P, char* smem) {
  char* ws = P.ws;
  const u16* xb = (const u16*)(ws + OFF_XB);
  const u16* WinT = (const u16*)(ws + OFF_WINT);
  u16* UG = (u16*)(ws + OFF_UG); u16* Qb = (u16*)(ws + OFF_QB); u16* Kb = (u16*)(ws + OFF_KB); u16* Vt = (u16*)(ws + OFF_VT);
  for (int tile = blockIdx.x; tile < 256 * 16; tile += gridDim.x) {
    const int brow = (tile >> 4) * 128, bcol = (tile & 15) * 128;
    gemm_tile(xb + (long)brow * 1024, 1024, WinT + (long)bcol * 1024, 1024, 0, 32, 0, 0, smem, [&](int row0, int col, f32x4 v) {
      const int r0 = brow + row0, c = bcol + col;
      if (bcol < 512) {
        const int g = c >> 4, hp = c & 15, m = r0 >> 6, j0 = r0 & 63;
        u16* dst = UG + ((long)g * 512 + m) * UGLD + j0 * 16 + hp;
#pragma unroll
        for (int j = 0; j < 4; ++j) dst[j * 16] = f2bf(v[j]);
      } else if (bcol < 1024) {
#pragma unroll
        for (int j = 0; j < 4; ++j) Qb[(long)(r0 + j) * 512 + (c - 512)] = f2bf(v[j]);
      } else if (bcol < 1536) {
#pragma unroll
        for (int j = 0; j < 4; ++j) Kb[(long)(r0 + j) * 512 + (c - 1024)] = f2bf(v[j]);
      } else {
        const int hd = c - 1536, b = r0 >> 13, l = r0 & 8191;
        *reinterpret_cast<uint2*>(Vt + ((long)(b * 512 + hd)) * 8192 + l) = make_uint2(pack2bf(v[0], v[1]), pack2bf(v[2], v[3]));
      }
    });
  }
  {
    const float* Ktab = (const float*)(ws + OFF_KTAB);
    u16* Wy = (u16*)(ws + OFF_WY);
    for (long idx = (long)blockIdx.x * 256 + threadIdx.x; idx < 32L * 1024 * 128; idx += (long)gridDim.x * 256) {
      int g = (int)(idx >> 17), n = (int)(idx >> 7) & 1023, k8 = (int)idx & 127, i = n >> 4, h = n & 15, j = k8 >> 1, hp0 = (k8 & 1) * 8;
      uint4 o = make_uint4(0, 0, 0, 0);
      if (j <= i) {
        const float4* kp = reinterpret_cast<const float4*>(Ktab + ((g * 64 + (i - j)) * 16 + h) * 16 + hp0);
        float4 a = kp[0], b = kp[1];
        o = make_uint4(pack2bf(a.x, a.y), pack2bf(a.z, a.w), pack2bf(b.x, b.y), pack2bf(b.z, b.w));
      }
      *reinterpret_cast<uint4*>(Wy + ((long)g * 1024 + n) * UGLD + k8 * 8) = o;
    }
  }
}

DI void phase2(const Params& P, char* smem) {
  char* ws = P.ws;
  const u16* UG = (const u16*)(ws + OFF_UG); const u16* Wst = (const u16*)(ws + OFF_WST);
  float* Sloc = (float*)(ws + OFF_SLOC);
  for (int tile = blockIdx.x; tile < 32 * 4; tile += gridDim.x) {
    const int g = tile >> 2, brow = (tile & 3) * 128;
    gemm_tile(UG + ((long)g * 512 + brow) * UGLD, UGLD, Wst + (long)g * 128 * 1024, 1024, 0, 32, 0, 0, smem, [&](int row0, int col, f32x4 v) {
#pragma unroll
      for (int j = 0; j < 4; ++j) Sloc[((long)g * 512 + brow + row0 + j) * 128 + col] = v[j];
    });
  }
  const u16* Kb = (const u16*)(ws + OFF_KB);
  float* kmean = (float*)(ws + OFF_KMEAN);
  float* red = (float*)smem;
  for (int item = blockIdx.x; item < 1024; item += gridDim.x) {
    const int bh = item >> 5, n = item & 31, b = bh >> 3, h = bh & 7, tid = threadIdx.x, d = tid & 63, part = tid >> 6;
    float s = 0.f;
    for (int kk = 0; kk < 64; ++kk) s += bf2f(Kb[((long)(b * 8192 + n * 256 + part * 64 + kk)) * 512 + h * 64 + d]);
    red[tid] = s;
    __syncthreads();
    if (tid < 64) kmean[(bh * 32 + n) * 64 + tid] = (red[tid] + red[tid + 64] + red[tid + 128] + red[tid + 192]) * (1.f / 256.f);
    __syncthreads();
  }
}

DI void phase3(const Params& P, char* smem) {
  char* ws = P.ws;
  {
    u16* UG = (u16*)(ws + OFF_UG); const float* Sloc = (const float*)(ws + OFF_SLOC);
    for (int id = blockIdx.x * 256 + threadIdx.x; id < 8192; id += gridDim.x * 256) {
      const int p = id & 63, b = (id >> 6) & 3, g = id >> 8;
      const float dt = expf(P.log_dt[g]);
      const float ar = P.a_re[g * 64 + p], ai = P.a_im[g * 64 + p];
      const float2 lamT = cexpf2(ar * dt * 64.f, ai * dt * 64.f);
      float2 s = make_float2(0.f, 0.f);
      for (int c = 0; c < 128; ++c) {
        const long m = (long)g * 512 + b * 128 + c;
        *reinterpret_cast<unsigned*>(UG + m * UGLD + 1024 + 2 * p) = pack2bf(s.x, s.y);
        const float2 loc = *reinterpret_cast<const float2*>(Sloc + m * 128 + 2 * p);
        s = cmul(lamT, s); s.x += loc.x; s.y += loc.y;
      }
    }
  }
  {
    const u16* Qb = (const u16*)(ws + OFF_QB);
    const float* kmean = (const float*)(ws + OFF_KMEAN);
    int* gcount = (int*)(ws + OFF_GCOUNT);
    u16* list = (u16*)(ws + OFF_LIST);
    float* km = (float*)smem;
    int* cnt = (int*)(smem + 31 * 64 * 4);
    int* base = cnt + 32;
    for (int item = blockIdx.x; item < 1024; item += gridDim.x) {
      const int bh = item >> 5, own = item & 31, b = bh >> 3, h = bh & 7, tid = threadIdx.x;
      if (own == 0) continue;
      for (int i = tid; i < own * 64; i += 256) km[i] = kmean[bh * 32 * 64 + i];
      if (tid < 32) cnt[tid] = 0;
      __syncthreads();
      const int l = own * 256 + tid;
      const u16* qrow = Qb + ((long)(b * 8192 + l)) * 512 + h * 64;
      float q[64];
#pragma unroll
      for (int c8 = 0; c8 < 8; ++c8) {
        uint4 w = *reinterpret_cast<const uint4*>(qrow + c8 * 8);
        q[c8 * 8 + 0] = __uint_as_float(w.x << 16); q[c8 * 8 + 1] = __uint_as_float(w.x & 0xffff0000u);
        q[c8 * 8 + 2] = __uint_as_float(w.y << 16); q[c8 * 8 + 3] = __uint_as_float(w.y & 0xffff0000u);
        q[c8 * 8 + 4] = __uint_as_float(w.z << 16); q[c8 * 8 + 5] = __uint_as_float(w.z & 0xffff0000u);
        q[c8 * 8 + 6] = __uint_as_float(w.w << 16); q[c8 * 8 + 7] = __uint_as_float(w.w & 0xffff0000u);
      }
      float v0 = -3e38f, v1 = -3e38f, v2 = -3e38f; int n0 = 0, n1 = 0, n2 = 0;
      for (int n = 0; n < own; ++n) {
        float s = 0.f;
#pragma unroll
        for (int d = 0; d < 64; ++d) s += q[d] * km[n * 64 + d];
        if (s > v2) {
          if (s > v1) { v2 = v1; n2 = n1; if (s > v0) { v1 = v0; n1 = n0; v0 = s; n0 = n; } else { v1 = s; n1 = n; } }
          else { v2 = s; n2 = n; }
        }
      }
      const int nsel = own < 3 ? own : 3;
      int p0 = 0, p1 = 0, p2 = 0;
      if (nsel > 0) p0 = atomicAdd(&cnt[n0], 1);
      if (nsel > 1) p1 = atomicAdd(&cnt[n1], 1);
      if (nsel > 2) p2 = atomicAdd(&cnt[n2], 1);
      __syncthreads();
      if (tid < 32) base[tid] = cnt[tid] > 0 ? atomicAdd(&gcount[bh * 32 + tid], cnt[tid]) : 0;
      __syncthreads();
      if (nsel > 0) list[((long)(bh * 32 + n0)) * 8192 + base[n0] + p0] = (u16)((l << 2) | 0);
      if (nsel > 1) list[((long)(bh * 32 + n1)) * 8192 + base[n1] + p1] = (u16)((l << 2) | 1);
      if (nsel > 2) list[((long)(bh * 32 + n2)) * 8192 + base[n2] + p2] = (u16)((l << 2) | 2);
      __syncthreads();
    }
  }
}

DI int crow(int i, int hh) { return (i & 3) + 8 * (i >> 2) + 4 * hh; }

DI void attn_item(const Params& P, int bh, int n, int t, int lane) {
  char* ws = P.ws;
  const u16* Qb = (const u16*)(ws + OFF_QB); const u16* Kb = (const u16*)(ws + OFF_KB); const u16* Vt = (const u16*)(ws + OFF_VT);
  const int* gcount = (const int*)(ws + OFF_GCOUNT); const u16* list = (const u16*)(ws + OFF_LIST);
  u16* Opart = (u16*)(ws + OFF_OPART); float* Lse = (float*)(ws + OFF_LSE);
  const int b = bh >> 3, h = bh & 7, r = lane & 31, hh = lane >> 5;
  const bool own = t < 8;
  int lq, slot; bool valid = true;
  if (own) { lq = n * 256 + t * 32 + r; slot = 3; }
  else {
    const int cnt = gcount[bh * 32 + n], idx = (t - 8) * 32 + r;
    valid = idx < cnt;
    const int e = list[((long)(bh * 32 + n)) * 8192 + (valid ? idx : 0)];
    lq = e >> 2; slot = e & 3;
  }
  bf16x8 qf[4];
  {
    const u16* qrow = Qb + ((long)(b * 8192 + lq)) * 512 + h * 64 + 8 * hh;
#pragma unroll
    for (int s = 0; s < 4; ++s) qf[s] = *reinterpret_cast<const bf16x8*>(qrow + 16 * s);
  }
  float m_run = -1e30f, l_run = 0.f;
  f32x16 O0, O1;
#pragma unroll
  for (int i = 0; i < 16; ++i) { O0[i] = 0.f; O1[i] = 0.f; }
  const int nkt = own ? (t + 1) : 8;
  for (int kt = 0; kt < nkt; ++kt) {
    const int kbase = n * 256 + kt * 32;
    f32x16 S;
#pragma unroll
    for (int i = 0; i < 16; ++i) S[i] = 0.f;
    const u16* krow = Kb + ((long)(b * 8192 + kbase + r)) * 512 + h * 64 + 8 * hh;
#pragma unroll
    for (int s = 0; s < 4; ++s) {
      bf16x8 kf = *reinterpret_cast<const bf16x8*>(krow + 16 * s);
      S = __builtin_amdgcn_mfma_f32_32x32x16_bf16(kf, qf[s], S, 0, 0, 0);
    }
    const bool diag = own && (kt == t);
    float mx = -1e30f;
#pragma unroll
    for (int i = 0; i < 16; ++i) {
      float sc = S[i] * 0.125f;
      if (diag && (kbase + crow(i, hh) > lq)) sc = -1e30f;
      S[i] = sc; mx = fmaxf(mx, sc);
    }
    mx = fmaxf(mx, __shfl_xor(mx, 32));
    const float m_new = fmaxf(m_run, mx);
    const float alpha = __expf(m_run - m_new);
    float rs = 0.f;
#pragma unroll
    for (int i = 0; i < 16; ++i) { float pv = __expf(S[i] - m_new); S[i] = pv; rs += pv; }
    rs += __shfl_xor(rs, 32);
    l_run = l_run * alpha + rs; m_run = m_new;
#pragma unroll
    for (int i = 0; i < 16; ++i) { O0[i] *= alpha; O1[i] *= alpha; }
#pragma unroll
    for (int s = 0; s < 2; ++s) {
      bf16x8 pf;
#pragma unroll
      for (int j = 0; j < 8; ++j) pf[j] = (short)f2bf(S[8 * s + j]);
#pragma unroll
      for (int dt = 0; dt < 2; ++dt) {
        const u16* vp = Vt + ((long)(bh * 64 + dt * 32 + r)) * 8192 + kbase + 16 * s + 4 * hh;
        uint2 lo = *reinterpret_cast<const uint2*>(vp), hi = *reinterpret_cast<const uint2*>(vp + 8);
        uint4 vv = make_uint4(lo.x, lo.y, hi.x, hi.y);
        bf16x8 vf = __builtin_bit_cast(bf16x8, vv);
        if (dt == 0) O0 = __builtin_amdgcn_mfma_f32_32x32x16_bf16(vf, pf, O0, 0, 0, 0);
        else O1 = __builtin_amdgcn_mfma_f32_32x32x16_bf16(vf, pf, O1, 0, 0, 0);
      }
    }
  }
  if (valid) {
    const float inv = 1.f / l_run;
    const long rowid = ((long)(b * 8192 + lq) * 8 + h) * 4 + slot;
    u16* op = Opart + rowid * 64;
#pragma unroll
    for (int gq = 0; gq < 4; ++gq) {
      *reinterpret_cast<uint2*>(op + 8 * gq + 4 * hh) = make_uint2(pack2bf(O0[4 * gq] * inv, O0[4 * gq + 1] * inv), pack2bf(O0[4 * gq + 2] * inv, O0[4 * gq + 3] * inv));
      *reinterpret_cast<uint2*>(op + 32 + 8 * gq + 4 * hh) = make_uint2(pack2bf(O1[4 * gq] * inv, O1[4 * gq + 1] * inv), pack2bf(O1[4 * gq + 2] * inv, O1[4 * gq + 3] * inv));
    }
    if (hh == 0) Lse[rowid] = m_run + __logf(l_run);
  }
}

DI void phase4(const Params& P, char* smem) {
  char* ws = P.ws;
  const u16* UG = (const u16*)(ws + OFF_UG); const u16* Wy = (const u16*)(ws + OFF_WY);
  u16* Yb = (u16*)(ws + OFF_YB);
  for (int tile = blockIdx.x; tile < 32 * 4 * 8; tile += gridDim.x) {
    const int g = tile >> 5, brow = ((tile >> 3) & 3) * 128, bcol = (tile & 7) * 128;
    gemm_tile(UG + ((long)g * 512 + brow) * UGLD, UGLD, Wy + ((long)g * 1024 + bcol) * UGLD, UGLD, 0, (bcol + 128) / 32, 32, 36, smem, [&](int row0, int col, f32x4 v) {
      const int n = bcol + col, i = n >> 4, h = n & 15;
      const float dsk = P.dsk[g * 16 + h];
#pragma unroll
      for (int j = 0; j < 4; ++j) {
        const int m = brow + row0 + j;
        const float u = bf2f(UG[((long)g * 512 + m) * UGLD + n]);
        Yb[((long)m * 64 + i) * 512 + g * 16 + h] = f2bf(gelu_t(v[j] + dsk * u));
      }
    });
  }
  const int wid = threadIdx.x >> 6, lane = threadIdx.x & 63;
  const int* gcount = (const int*)(ws + OFF_GCOUNT);
  for (long w = (long)blockIdx.x * 4 + wid; w < 1024L * 256; w += (long)gridDim.x * 4) {
    const int bhn = (int)(w >> 8), t = (int)(w & 255), n = bhn & 31, bh = bhn >> 5;
    if (t >= 8) { const int cnt = gcount[bhn]; if ((t - 8) * 32 >= cnt) continue; }
    attn_item(P, bh, n, t, lane);
  }
}

DI void phase5(const Params& P, char* smem) {
  char* ws = P.ws;
  const u16* Yb = (const u16*)(ws + OFF_YB); const u16* WgT = (const u16*)(ws + OFF_WGT);
  u16* cat = (u16*)(ws + OFF_CAT);
  for (int tile = blockIdx.x; tile < 256 * 4; tile += gridDim.x) {
    const int brow = (tile >> 2) * 128, bcol = (tile & 3) * 128;
    gemm_tile(Yb + (long)brow * 512, 512, WgT + (long)bcol * 512, 512, 0, 16, 0, 0, smem, [&](int row0, int col, f32x4 v) {
#pragma unroll
      for (int j = 0; j < 4; ++j) {
        const long r = brow + row0 + j; const int c = bcol + col;
        const float y = bf2f(Yb[r * 512 + c]);
        cat[r * 1024 + c] = f2bf(y / (1.f + __expf(-v[j])));
      }
    });
  }
  const u16* Opart = (const u16*)(ws + OFF_OPART); const float* Lse = (const float*)(ws + OFF_LSE);
  for (long idx = (long)blockIdx.x * 256 + threadIdx.x; idx < (long)NTOK * 64; idx += (long)gridDim.x * 256) {
    const int dg = (int)idx & 7, h = (int)(idx >> 3) & 7; const long tok = idx >> 6;
    const int l = (int)(tok & 8191); const int ownb = l >> 8; const int nv = ownb < 3 ? ownb : 3;
    const long base = (tok * 8 + h) * 4;
    float ls[4]; float mx = -3e38f;
#pragma unroll
    for (int s = 0; s < 4; ++s) { const bool ok = (s == 3) || (s < nv); ls[s] = ok ? Lse[base + s] : -3e38f; mx = fmaxf(mx, ls[s]); }
    float acc[8]; float wsum = 0.f;
#pragma unroll
    for (int k = 0; k < 8; ++k) acc[k] = 0.f;
#pragma unroll
    for (int s = 0; s < 4; ++s) {
      const bool ok = (s == 3) || (s < nv);
      if (ok) {
        const float w = __expf(ls[s] - mx); wsum += w;
        uint4 o = *reinterpret_cast<const uint4*>(Opart + (base + s) * 64 + dg * 8);
        acc[0] += w * __uint_as_float(o.x << 16); acc[1] += w * __uint_as_float(o.x & 0xffff0000u);
        acc[2] += w * __uint_as_float(o.y << 16); acc[3] += w * __uint_as_float(o.y & 0xffff0000u);
        acc[4] += w * __uint_as_float(o.z << 16); acc[5] += w * __uint_as_float(o.z & 0xffff0000u);
        acc[6] += w * __uint_as_float(o.w << 16); acc[7] += w * __uint_as_float(o.w & 0xffff0000u);
      }
    }
    const float inv = 1.f / wsum;
    *reinterpret_cast<uint4*>(cat + tok * 1024 + 512 + h * 64 + dg * 8) =
        make_uint4(pack2bf(acc[0] * inv, acc[1] * inv), pack2bf(acc[2] * inv, acc[3] * inv), pack2bf(acc[4] * inv, acc[5] * inv), pack2bf(acc[6] * inv, acc[7] * inv));
  }
}

DI void phase6(const Params& P, char* smem) {
  char* ws = P.ws;
  const u16* cat = (const u16*)(ws + OFF_CAT); const u16* WoT = (const u16*)(ws + OFF_WOT);
  float* Z1 = (float*)(ws + OFF_Z1);
  for (int tile = blockIdx.x; tile < 256 * 8; tile += gridDim.x) {
    const int brow = (tile >> 3) * 128, bcol = (tile & 7) * 128;
    gemm_tile(cat + (long)brow * 1024, 1024, WoT + (long)bcol * 1024, 1024, 0, 32, 0, 0, smem, [&](int row0, int col, f32x4 v) {
#pragma unroll
      for (int j = 0; j < 4; ++j) { const long o = (long)(brow + row0 + j) * 1024 + bcol + col; Z1[o] = ALPHA * P.x[o] + v[j]; }
    });
  }
}

DI void phase7(const Params& P, char* smem) {
  char* ws = P.ws;
  const float* Z1 = (const float*)(ws + OFF_Z1);
  _Float16* h1h = (_Float16*)(ws + OFF_H1H); u16* h1b = (u16*)(ws + OFF_H1B);
  const int wid = threadIdx.x >> 6, lane = threadIdx.x & 63;
  for (int row = blockIdx.x * 4 + wid; row < NTOK; row += gridDim.x * 4) {
    float4 z[4]; float s = 0.f;
#pragma unroll
    for (int k = 0; k < 4; ++k) { z[k] = *reinterpret_cast<const float4*>(Z1 + (long)row * 1024 + k * 256 + lane * 4); s += z[k].x + z[k].y + z[k].z + z[k].w; }
    const float mu = wave_sum(s) * (1.f / 1024.f);
    float q = 0.f;
#pragma unroll
    for (int k = 0; k < 4; ++k) { float a = z[k].x - mu, b = z[k].y - mu, c = z[k].z - mu, d = z[k].w - mu; q += a * a + b * b + c * c + d * d; }
    const float rstd = rsqrtf(wave_sum(q) * (1.f / 1024.f) + 1e-5f);
#pragma unroll
    for (int k = 0; k < 4; ++k) {
      const int c0 = k * 256 + lane * 4;
      const float4 gg = *reinterpret_cast<const float4*>(P.ln1g + c0), bb = *reinterpret_cast<const float4*>(P.ln1b + c0);
      const float y0 = (z[k].x - mu) * rstd * gg.x + bb.x, y1 = (z[k].y - mu) * rstd * gg.y + bb.y, y2 = (z[k].z - mu) * rstd * gg.z + bb.z, y3 = (z[k].w - mu) * rstd * gg.w + bb.w;
      typedef _Float16 h4 __attribute__((ext_vector_type(4)));
      h4 hv; hv[0] = (_Float16)y0; hv[1] = (_Float16)y1; hv[2] = (_Float16)y2; hv[3] = (_Float16)y3;
      *reinterpret_cast<h4*>(h1h + (long)row * 1024 + c0) = hv;
      *reinterpret_cast<uint2*>(h1b + (long)row * 1024 + c0) = make_uint2(pack2bf(y0, y1), pack2bf(y2, y3));
    }
  }
  cvt_f16(P.pu, 16384L * 1024, (_Float16*)(ws + OFF_UH));
  cvt_f16(P.pv, 16384L * 1024, (_Float16*)(ws + OFF_VH));
}

DI void phase8(const Params& P, char* smem) {
  char* ws = P.ws;
  const u16* h1b = (const u16*)(ws + OFF_H1B); const u16* WqT = (const u16*)(ws + OFF_WQT);
  u16* Qp = (u16*)(ws + OFF_QP);
  for (int tile = blockIdx.x; tile < 256 * 16; tile += gridDim.x) {
    const int brow = (tile >> 4) * 128, bcol = (tile & 15) * 128;
    gemm_tile(h1b + (long)brow * 1024, 1024, WqT + (long)bcol * 1024, 1024, 0, 32, 0, 0, smem, [&](int row0, int col, f32x4 v) {
#pragma unroll
      for (int j = 0; j < 4; ++j) Qp[(long)(brow + row0 + j) * 2048 + bcol + col] = f2bf(v[j]);
    });
  }
}

DI void phase9(const Params& P, char* smem) {
  char* ws = P.ws;
  const u16* Qp = (const u16*)(ws + OFF_QP); const u16* SKb = (const u16*)(ws + OFF_SKB);
  _Float16* ST = (_Float16*)(ws + OFF_ST);
  for (int tile = blockIdx.x; tile < 256 * 16; tile += gridDim.x) {
    const int brow = (tile >> 4) * 128, hc = tile & 15;
    gemm_tile(Qp + (long)brow * 2048 + hc * 128, 2048, SKb + (long)hc * 128 * 128, 128, 0, 4, 0, 0, smem, [&](int row0, int col, f32x4 v) {
      typedef _Float16 h4 __attribute__((ext_vector_type(4)));
      h4 hv; hv[0] = (_Float16)v[0]; hv[1] = (_Float16)v[1]; hv[2] = (_Float16)v[2]; hv[3] = (_Float16)v[3];
      *reinterpret_cast<h4*>(ST + ((long)(hc * 128 + col)) * NTOK + brow + row0) = hv;
    });
  }
}

#define BUBBLE16(V, I)                                                                              \
  _Pragma("unroll") for (int k_ = 15; k_ >= 1; --k_) {                                              \
    const bool sw_ = V[k_] > V[k_ - 1];                                                             \
    const float a_ = sw_ ? V[k_] : V[k_ - 1], b_ = sw_ ? V[k_ - 1] : V[k_];                         \
    const int ia_ = sw_ ? I[k_] : I[k_ - 1], ib_ = sw_ ? I[k_ - 1] : I[k_];                         \
    V[k_ - 1] = a_; V[k_] = b_; I[k_ - 1] = ia_; I[k_] = ib_;                                       \
  }

DI void phase10(const Params& P, char* smem) {
  char* ws = P.ws;
  const _Float16* ST = (const _Float16*)(ws + OFF_ST);
  int* Eidx = (int*)(ws + OFF_EIDX); float* G = (float*)(ws + OFF_G);
  for (long id = (long)blockIdx.x * 256 + threadIdx.x; id < (long)NTOK * 8; id += (long)gridDim.x * 256) {
    const int t = (int)(id & (NTOK - 1)), h = (int)(id >> 15);
    float v1[16], v2[16]; int i1[16], i2[16];
#pragma unroll
    for (int k = 0; k < 16; ++k) { v1[k] = -3e38f; v2[k] = -3e38f; i1[k] = 0; i2[k] = 0; }
    const _Float16* s1 = ST + ((long)(h * 2 + 0) * 128) * NTOK + t;
    const _Float16* s2 = ST + ((long)(h * 2 + 1) * 128) * NTOK + t;
    for (int n = 0; n < 128; ++n) {
      const float a = (float)s1[(long)n * NTOK], b = (float)s2[(long)n * NTOK];
      if (a > v1[15]) { v1[15] = a; i1[15] = n; BUBBLE16(v1, i1) }
      if (b > v2[15]) { v2[15] = b; i2[15] = n; BUBBLE16(v2, i2) }
    }
    float tv[16]; int te[16];
#pragma unroll
    for (int k = 0; k < 16; ++k) { tv[k] = -3e38f; te[k] = 0; }
#pragma unroll
    for (int a = 0; a < 16; ++a) {
#pragma unroll
      for (int b = 0; b < 16; ++b) {
        if ((a + 1) * (b + 1) <= 16) {
          const float c = v1[a] + v2[b];
          if (c > tv[15]) { tv[15] = c; te[15] = i1[a] * 128 + i2[b]; BUBBLE16(tv, te) }
        }
      }
    }
    float e[16], sum = 0.f;
#pragma unroll
    for (int k = 0; k < 16; ++k) { e[k] = __expf(tv[k] - tv[0]); sum += e[k]; }
    const float inv = 1.f / sum;
    int4* ep = reinterpret_cast<int4*>(Eidx + ((long)t * 8 + h) * 16);
    float4* gp = reinterpret_cast<float4*>(G + ((long)t * 8 + h) * 16);
#pragma unroll
    for (int k = 0; k < 4; ++k) {
      ep[k] = make_int4(te[4 * k], te[4 * k + 1], te[4 * k + 2], te[4 * k + 3]);
      gp[k] = make_float4(e[4 * k] * inv, e[4 * k + 1] * inv, e[4 * k + 2] * inv, e[4 * k + 3] * inv);
    }
  }
}

DI void peer_pairs(const _Float16* __restrict__ Uh, const _Float16* __restrict__ Vh, int Ereg, float Greg, const h2 (&xh)[8], float (&acc)[16], int lane) {
  for (int i0 = 0; i0 < 64; i0 += 4) {
    h8 ua[4], ub[4], va[4], vb[4]; float gw[4];
#pragma unroll
    for (int q = 0; q < 4; ++q) {
      const int e = __builtin_amdgcn_readlane(Ereg, i0 + q);
      gw[q] = __int_as_float(__builtin_amdgcn_readlane(__float_as_int(Greg), i0 + q));
      const _Float16* up = Uh + (long)e * 1024 + lane * 16;
      const _Float16* vp = Vh + (long)e * 1024 + lane * 16;
      ua[q] = *reinterpret_cast<const h8*>(up); ub[q] = *reinterpret_cast<const h8*>(up + 8);
      va[q] = *reinterpret_cast<const h8*>(vp); vb[q] = *reinterpret_cast<const h8*>(vp + 8);
    }
#pragma unroll
    for (int q = 0; q < 4; ++q) {
      float d = 0.f;
#pragma unroll
      for (int k = 0; k < 4; ++k) {
        h2 a; a[0] = ua[q][2 * k]; a[1] = ua[q][2 * k + 1];
        h2 b; b[0] = ub[q][2 * k]; b[1] = ub[q][2 * k + 1];
        d = __builtin_amdgcn_fdot2(a, xh[k], d, false);
        d = __builtin_amdgcn_fdot2(b, xh[4 + k], d, false);
      }
      d = wave_sum(d);
      const float w = gw[q] * gelu_t(d);
#pragma unroll
      for (int k = 0; k < 8; ++k) { acc[k] = fmaf(w, (float)va[q][k], acc[k]); acc[8 + k] = fmaf(w, (float)vb[q][k], acc[8 + k]); }
    }
  }
}

DI void phase11(const Params& P, char* smem) {
  char* ws = P.ws;
  const _Float16* h1h = (const _Float16*)(ws + OFF_H1H);
  const _Float16* Uh = (const _Float16*)(ws + OFF_UH); const _Float16* Vh = (const _Float16*)(ws + OFF_VH);
  const int* Eidx = (const int*)(ws + OFF_EIDX); const float* G = (const float*)(ws + OFF_G);
  const int wid = threadIdx.x >> 6, lane = threadIdx.x & 63;
  for (int t = blockIdx.x * 4 + wid; t < NTOK; t += gridDim.x * 4) {
    const h8 x0 = *reinterpret_cast<const h8*>(h1h + (long)t * 1024 + lane * 16);
    const h8 x1 = *reinterpret_cast<const h8*>(h1h + (long)t * 1024 + lane * 16 + 8);
    h2 xh[8];
#pragma unroll
    for (int k = 0; k < 4; ++k) { xh[k][0] = x0[2 * k]; xh[k][1] = x0[2 * k + 1]; xh[4 + k][0] = x1[2 * k]; xh[4 + k][1] = x1[2 * k + 1]; }
    const int E0 = Eidx[(long)t * 128 + lane], E1 = Eidx[(long)t * 128 + 64 + lane];
    const float G0 = G[(long)t * 128 + lane], G1 = G[(long)t * 128 + 64 + lane];
    float acc[16];
#pragma unroll
    for (int k = 0; k < 16; ++k) acc[k] = 0.f;
    peer_pairs(Uh, Vh, E0, G0, xh, acc, lane);
    peer_pairs(Uh, Vh, E1, G1, xh, acc, lane);
    float z[16]; float s = 0.f;
#pragma unroll
    for (int k = 0; k < 8; ++k) { z[k] = ALPHA * (float)x0[k] + acc[k]; z[8 + k] = ALPHA * (float)x1[k] + acc[8 + k]; }
#pragma unroll
    for (int k = 0; k < 16; ++k) s += z[k];
    const float mu = wave_sum(s) * (1.f / 1024.f);
    float q = 0.f;
#pragma unroll
    for (int k = 0; k < 16; ++k) { const float d = z[k] - mu; q += d * d; }
    const float rstd = rsqrtf(wave_sum(q) * (1.f / 1024.f) + 1e-5f);
#pragma unroll
    for (int k = 0; k < 4; ++k) {
      const int c0 = lane * 16 + k * 4;
      const float4 gg = *reinterpret_cast<const float4*>(P.ln2g + c0), bb = *reinterpret_cast<const float4*>(P.ln2b + c0);
      float4 o;
      o.x = (z[4 * k] - mu) * rstd * gg.x + bb.x; o.y = (z[4 * k + 1] - mu) * rstd * gg.y + bb.y;
      o.z = (z[4 * k + 2] - mu) * rstd * gg.z + bb.z; o.w = (z[4 * k + 3] - mu) * rstd * gg.w + bb.w;
      *reinterpret_cast<float4*>(P.out + (long)t * 1024 + c0) = o;
    }
  }
}

template <int PH> DI void run_phase(const Params& P, char* smem) {
  if (PH == 0) phase0(P, smem); else if (PH == 1) phase1(P, smem); else if (PH == 2) phase2(P, smem); else if (PH == 3) phase3(P, smem);
  else if (PH == 4) phase4(P, smem); else if (PH == 5) phase5(P, smem); else if (PH == 6) phase6(P, smem); else if (PH == 7) phase7(P, smem);
  else if (PH == 8) phase8(P, smem); else if (PH == 9) phase9(P, smem); else if (PH == 10) phase10(P, smem); else phase11(P, smem);
}

template <int PH> __global__ void __launch_bounds__(256, 2) k_phase(Params P) {
  __shared__ __attribute__((aligned(16))) char smem[16384];
  run_phase<PH>(P, smem);
}

__global__ void __launch_bounds__(256, 2) k_mega(Params P) {
  __shared__ __attribute__((aligned(16))) char smem[16384];
  cg::grid_group grid = cg::this_grid();
  phase0(P, smem); grid.sync();
  phase1(P, smem); grid.sync();
  phase2(P, smem); grid.sync();
  phase3(P, smem); grid.sync();
  phase4(P, smem); grid.sync();
  phase5(P, smem); grid.sync();
  phase6(P, smem); grid.sync();
  phase7(P, smem); grid.sync();
  phase8(P, smem); grid.sync();
  phase9(P, smem); grid.sync();
  phase10(P, smem); grid.sync();
  phase11(P, smem);
}

extern "C" void kernel_launch(void* const* d_in, const int* in_sizes, int n_in, void* d_out, int out_size, void* d_ws, size_t ws_size, hipStream_t stream) {
  if (ws_size < WS_NEED) { fprintf(stderr, "workspace too small: %zu\n", ws_size); return; }
  Params P{};
  P.x = (const float*)d_in[0]; P.w_in = (const float*)d_in[1]; P.a_re = (const float*)d_in[2]; P.a_im = (const float*)d_in[3];
  P.log_dt = (const float*)d_in[4]; P.b_re = (const float*)d_in[5]; P.b_im = (const float*)d_in[6]; P.c_re = (const float*)d_in[7];
  P.c_im = (const float*)d_in[8]; P.dsk = (const float*)d_in[9]; P.w_glu = (const float*)d_in[10]; P.w_out = (const float*)d_in[11];
  P.ln1g = (const float*)d_in[12]; P.ln1b = (const float*)d_in[13]; P.w_q = (const float*)d_in[14]; P.subk = (const float*)d_in[15];
  P.pu = (const float*)d_in[16]; P.pv = (const float*)d_in[17]; P.ln2g = (const float*)d_in[18]; P.ln2b = (const float*)d_in[19];
  P.out = (float*)d_out; P.ws = (char*)d_ws;
#if MULTI_LAUNCH
  const int grid = 512;
  k_phase<0><<<grid, 256, 0, stream>>>(P);
  k_phase<1><<<grid, 256, 0, stream>>>(P);
  k_phase<2><<<grid, 256, 0, stream>>>(P);
  k_phase<3><<<grid, 256, 0, stream>>>(P);
  k_phase<4><<<grid, 256, 0, stream>>>(P);
  k_phase<5><<<grid, 256, 0, stream>>>(P);
  k_phase<6><<<grid, 256, 0, stream>>>(P);
  k_phase<7><<<grid, 256, 0, stream>>>(P);
  k_phase<8><<<grid, 256, 0, stream>>>(P);
  k_phase<9><<<grid, 256, 0, stream>>>(P);
  k_phase<10><<<grid, 256, 0, stream>>>(P);
  k_phase<11><<<grid, 256, 0, stream>>>(P);
#else
  static int grid_blocks = 0;
  if (!grid_blocks) {
    int dev = 0, cus = 0, per_cu = 0;
    hipGetDevice(&dev);
    hipDeviceGetAttribute(&cus, hipDeviceAttributeMultiprocessorCount, dev);
    hipOccupancyMaxActiveBlocksPerMultiprocessor(&per_cu, k_mega, 256, 0);
    if (per_cu > 2) per_cu = 2;
    grid_blocks = cus * per_cu;
  }
  void* args[] = {&P};
  hipError_t e = hipLaunchCooperativeKernel((void*)k_mega, dim3(grid_blocks), dim3(256), args, 0, stream);
  if (e != hipSuccess) fprintf(stderr, "cooperative launch failed: %s (grid %d)\n", hipGetErrorString(e), grid_blocks);
#endif
}
```

```cpp
#include <hip/hip_runtime.h>
#include <hip/hip_cooperative_groups.h>
#include <cstdio>
#include <cstdint>
namespace cg = cooperative_groups;

#ifndef PROBE_DUP
#define PROBE_DUP -1
#endif
#define DI __device__ __forceinline__
#define RBLK ((int)blockIdx.x)
#define RGRID ((int)gridDim.x)
#define RTID ((int)threadIdx.x)
#define VHALF (RTID >> 8)
#define VT (RTID & 255)
#define VB (RBLK * 2 + VHALF)
#define NVB (RGRID * 2)
constexpr int VLDS = 70912;

typedef unsigned short u16;
using bf16x8 = __attribute__((ext_vector_type(8))) short;
using f32x4  = __attribute__((ext_vector_type(4))) float;
using f32x16 = __attribute__((ext_vector_type(16))) float;
typedef _Float16 h2 __attribute__((ext_vector_type(2)));
typedef _Float16 h8 __attribute__((ext_vector_type(8)));

constexpr int NTOK = 32768, DM = 1024, SEQ = 8192;
constexpr float ALPHA = 1.189207115002721f;
constexpr size_t MB = 1u << 20;
constexpr size_t OFF_QB = 0, OFF_KB = 32 * MB, OFF_UH = 0, OFF_VH = 32 * MB;
constexpr size_t OFF_UQ = 0, OFF_VQ = 16 * MB, OFF_US = 32 * MB, OFF_VS = 33 * MB;
constexpr size_t OFF_XQ = 400 * MB, OFF_SX = 432 * MB, OFF_W2 = 434 * MB, OFF_E2 = 450 * MB, OFF_ZP = 160 * MB;
constexpr size_t OFF_XB = 64 * MB, OFF_YB = 64 * MB, OFF_H1H = 64 * MB;
constexpr size_t OFF_OPART = 128 * MB, OFF_LSE = 256 * MB, OFF_Z1 = 128 * MB, OFF_QP = 128 * MB, OFF_EIDX = 128 * MB, OFF_G = 144 * MB;
constexpr size_t OFF_WY = 260 * MB, OFF_WST = 332 * MB, OFF_SLOC = 340 * MB, OFF_LIST = 348 * MB;
constexpr size_t OFF_H1B = 256 * MB, OFF_ST = 256 * MB;
constexpr size_t OFF_WINT = 384 * MB, OFF_WQT = 388 * MB, OFF_WOT = 392 * MB, OFF_WGT = 394 * MB, OFF_SKB = 394 * MB + 512 * 1024;
constexpr size_t OFF_KTAB = 395 * MB, OFF_KMEAN = 397 * MB, OFF_GCOUNT = 397 * MB + 256 * 1024;
constexpr size_t OFF_VT = 400 * MB, OFF_CAT = 400 * MB, OFF_UG = 464 * MB;
constexpr size_t WS_NEED = 500 * MB;
constexpr size_t OFF_BAR = 398 * MB;
constexpr int UGLD = 1152;
constexpr int LDS_BYTES = 2 * 70912 + 16;

struct Params {
  const float *x, *w_in, *a_re, *a_im, *log_dt, *b_re, *b_im, *c_re, *c_im, *dsk, *w_glu, *w_out, *ln1g, *ln1b, *w_q, *subk, *pu, *pv, *ln2g, *ln2b;
  float* out;
  char* ws;
};

typedef __bf16 bf2_t __attribute__((ext_vector_type(2)));
typedef float f2_t __attribute__((ext_vector_type(2)));
DI unsigned pack2bf(float a, float b) { const f2_t v = {a, b}; return __builtin_bit_cast(unsigned, __builtin_convertvector(v, bf2_t)); }
DI u16 f2bf(float x) { return (u16)(pack2bf(x, 0.f) & 0xffffu); }
DI float bf2f(u16 b) { return __uint_as_float(((unsigned)b) << 16); }
DI float gelu_t(float x) { float u = 0.7978845608028654f * (x + 0.044715f * x * x * x); float e = __expf(2.f * u); float t = 1.f - 2.f / (1.f + e); return 0.5f * x * (1.f + t); }
DI float2 cmul(float2 a, float2 b) { return make_float2(a.x * b.x - a.y * b.y, a.x * b.y + a.y * b.x); }
DI float2 cexpf2(float re, float im) { float e = expf(re); float s, c; sincosf(im, &s, &c); return make_float2(e * c, e * s); }
DI float dpp_row_sum_f0(float v) {
  v += __int_as_float(__builtin_amdgcn_update_dpp(0, __float_as_int(v), 0xB1, 0xF, 0xF, true));
  v += __int_as_float(__builtin_amdgcn_update_dpp(0, __float_as_int(v), 0x4E, 0xF, 0xF, true));
  v += __int_as_float(__builtin_amdgcn_update_dpp(0, __float_as_int(v), 0x141, 0xF, 0xF, true));
  v += __int_as_float(__builtin_amdgcn_update_dpp(0, __float_as_int(v), 0x140, 0xF, 0xF, true));
  return v;
}
DI float rl_f(float v, int l) { return __int_as_float(__builtin_amdgcn_readlane(__float_as_int(v), l)); }
DI float wave_sum(float v) { v = dpp_row_sum_f0(v); return (rl_f(v, 0) + rl_f(v, 16)) + (rl_f(v, 32) + rl_f(v, 48)); }
DI float wave_max(float v) {
  v = fmaxf(v, __int_as_float(__builtin_amdgcn_update_dpp(0, __float_as_int(v), 0xB1, 0xF, 0xF, true)));
  v = fmaxf(v, __int_as_float(__builtin_amdgcn_update_dpp(0, __float_as_int(v), 0x4E, 0xF, 0xF, true)));
  v = fmaxf(v, __int_as_float(__builtin_amdgcn_update_dpp(0, __float_as_int(v), 0x141, 0xF, 0xF, true)));
  v = fmaxf(v, __int_as_float(__builtin_amdgcn_update_dpp(0, __float_as_int(v), 0x140, 0xF, 0xF, true)));
  return fmaxf(fmaxf(rl_f(v, 0), rl_f(v, 16)), fmaxf(rl_f(v, 32), rl_f(v, 48)));
}

template <bool SWAP, class Epi>
DI void gemm_tile(const u16* __restrict__ Ag, long lda, const u16* __restrict__ Bg, long ldb, int ka0, int ka1, int kb0, int kb1, char* shm, Epi&& epi) {
  const int tid = VT, wid = tid >> 6, lane = tid & 63, wr = wid >> 1, wc = wid & 1, fr = lane & 15, fq = lane >> 4;
  const int na = ka1 - ka0, nk = na + (kb1 - kb0);
  f32x4 acc[4][4];
#pragma unroll
  for (int m = 0; m < 4; ++m)
#pragma unroll
    for (int n = 0; n < 4; ++n) acc[m][n] = f32x4{0.f, 0.f, 0.f, 0.f};
  auto stage = [&](int buf, int kt) {
    char* SA = shm + buf * 32768; char* SB = SA + 16384;
#pragma unroll
    for (int i = 0; i < 4; ++i) {
      const int q = i * 256 + tid, r = q >> 3, c16 = (q & 7) ^ ((r >> 1) & 7);
      __builtin_amdgcn_global_load_lds((const unsigned*)(Ag + (long)r * lda + kt * 64 + c16 * 8), (__attribute__((address_space(3))) unsigned*)(SA + q * 16), 16, 0, 0);
      __builtin_amdgcn_global_load_lds((const unsigned*)(Bg + (long)r * ldb + kt * 64 + c16 * 8), (__attribute__((address_space(3))) unsigned*)(SB + q * 16), 16, 0, 0);
    }
  };
  stage(0, ka0 < ka1 ? ka0 : kb0);
  for (int i = 0; i < nk; ++i) {
    asm volatile("s_waitcnt vmcnt(0)" ::: "memory");
    __syncthreads();
    if (i + 1 < nk) { const int j = i + 1; stage(j & 1, j < na ? ka0 + j : kb0 + (j - na)); }
    const char* SA = shm + (i & 1) * 32768; const char* SB = SA + 16384;
#pragma unroll
    for (int ks = 0; ks < 2; ++ks) {
      bf16x8 At[4], Bt[4];
#pragma unroll
      for (int m = 0; m < 4; ++m) {
        const int ra = wr * 64 + m * 16 + fr, rb = wc * 64 + m * 16 + fr;
        At[m] = *reinterpret_cast<const bf16x8*>(SA + ra * 128 + (((ks * 4 + fq) ^ ((ra >> 1) & 7)) * 16));
        Bt[m] = *reinterpret_cast<const bf16x8*>(SB + rb * 128 + (((ks * 4 + fq) ^ ((rb >> 1) & 7)) * 16));
      }
#pragma unroll
      for (int m = 0; m < 4; ++m)
#pragma unroll
        for (int n = 0; n < 4; ++n) acc[m][n] = SWAP ? __builtin_amdgcn_mfma_f32_16x16x32_bf16(Bt[n], At[m], acc[m][n], 0, 0, 0) : __builtin_amdgcn_mfma_f32_16x16x32_bf16(At[m], Bt[n], acc[m][n], 0, 0, 0);
    }
  }
  __syncthreads();
#pragma unroll
  for (int m = 0; m < 4; ++m)
#pragma unroll
    for (int n = 0; n < 4; ++n) { if (SWAP) epi(wr * 64 + m * 16 + fr, wc * 64 + n * 16 + fq * 4, acc[m][n]); else epi(wr * 64 + m * 16 + fq * 4, wc * 64 + n * 16 + fr, acc[m][n]); }
}

template <class Epi>
DI void gemm_tile256(const u16* __restrict__ Ag, long lda, const u16* __restrict__ Bg, long ldb, int nk, char* shm, Epi&& epi) {
  const int tid = RTID, wid = tid >> 6, lane = tid & 63, wr = wid >> 2, wc = wid & 3, fr = lane & 15, fq = lane >> 4;
  f32x4 acc[8][4];
#pragma unroll
  for (int m = 0; m < 8; ++m)
#pragma unroll
    for (int n = 0; n < 4; ++n) acc[m][n] = f32x4{0.f, 0.f, 0.f, 0.f};
  const int q0 = tid, q1 = 512 + tid;
  const int r0 = q0 >> 2, r1 = q1 >> 2, c0 = (q0 & 3) ^ ((r0 >> 2) & 3), c1 = (q1 & 3) ^ ((r1 >> 2) & 3);
  const u16* a0 = Ag + (long)r0 * lda + c0 * 8; const u16* a1 = Ag + (long)r1 * lda + c1 * 8;
  const u16* b0 = Bg + (long)r0 * ldb + c0 * 8; const u16* b1 = Bg + (long)r1 * ldb + c1 * 8;
  auto stage = [&](int j) {
    char* SA = shm + (j & 3) * 32768; char* SB = SA + 16384;
    __builtin_amdgcn_global_load_lds((const unsigned*)(a0 + j * 32), (__attribute__((address_space(3))) unsigned*)(SA + q0 * 16), 16, 0, 0);
    __builtin_amdgcn_global_load_lds((const unsigned*)(a1 + j * 32), (__attribute__((address_space(3))) unsigned*)(SA + q1 * 16), 16, 0, 0);
    __builtin_amdgcn_global_load_lds((const unsigned*)(b0 + j * 32), (__attribute__((address_space(3))) unsigned*)(SB + q0 * 16), 16, 0, 0);
    __builtin_amdgcn_global_load_lds((const unsigned*)(b1 + j * 32), (__attribute__((address_space(3))) unsigned*)(SB + q1 * 16), 16, 0, 0);
  };
  __syncthreads();
  stage(0);
  if (nk > 1) stage(1);
  if (nk > 2) stage(2);
  for (int i = 0; i < nk; ++i) {
    if (i + 2 < nk) asm volatile("s_waitcnt vmcnt(8)" ::: "memory");
    else if (i + 1 < nk) asm volatile("s_waitcnt vmcnt(4)" ::: "memory");
    else asm volatile("s_waitcnt vmcnt(0)" ::: "memory");
    __builtin_amdgcn_s_barrier();
    __builtin_amdgcn_sched_barrier(0);
    const char* SA = shm + (i & 3) * 32768; const char* SB = SA + 16384;
    bf16x8 At[8], Bt[4];
#pragma unroll
    for (int n = 0; n < 4; ++n) { const int rb = wc * 64 + n * 16 + fr; Bt[n] = *reinterpret_cast<const bf16x8*>(SB + rb * 64 + ((fq ^ ((rb >> 2) & 3)) * 16)); }
#pragma unroll
    for (int m = 0; m < 8; ++m) { const int ra = wr * 128 + m * 16 + fr; At[m] = *reinterpret_cast<const bf16x8*>(SA + ra * 64 + ((fq ^ ((ra >> 2) & 3)) * 16)); }
    if (i + 3 < nk) stage(i + 3);
#pragma unroll
    for (int m = 0; m < 8; ++m)
#pragma unroll
      for (int n = 0; n < 4; ++n) acc[m][n] = __builtin_amdgcn_mfma_f32_16x16x32_bf16(Bt[n], At[m], acc[m][n], 0, 0, 0);
  }
  __syncthreads();
#pragma unroll
  for (int m = 0; m < 8; ++m)
#pragma unroll
    for (int n = 0; n < 4; ++n) epi(wr * 128 + m * 16 + fr, wc * 64 + n * 16 + fq * 4, acc[m][n]);
}

DI int xcd_tile(int q, int x, int C) { if (C >= 8) { const int cpx = C >> 3; return (q / cpx) * C + x * cpx + q % cpx; } const int rpx = 8 / C; return (q * rpx + x / C) * C + (x % C); }
#define TILE_LOOP(tile, N, C)                                                                                          \
  for (int q0_ = (RBLK >> 3) * 2, tile = 0;                                                                            \
       q0_ < (N) / 8 && ((tile = xcd_tile((q0_ + VHALF < (N) / 8 ? q0_ + VHALF : q0_), RBLK & 7, (C))), true);          \
       q0_ += (RGRID >> 3) * 2)

DI void transpose_bf16(const float* __restrict__ src, int K, int N, u16* __restrict__ dst) {
  const long total = (long)(K / 8) * N;
  for (long idx = (long)VB * 256 + VT; idx < total; idx += (long)NVB * 256) {
    int n = (int)(idx % N), k8 = (int)(idx / N);
    unsigned w[4];
#pragma unroll
    for (int j = 0; j < 4; ++j) w[j] = pack2bf(src[(long)(k8 * 8 + 2 * j) * N + n], src[(long)(k8 * 8 + 2 * j + 1) * N + n]);
    *reinterpret_cast<uint4*>(dst + (long)n * K + k8 * 8) = make_uint4(w[0], w[1], w[2], w[3]);
  }
}
DI void cvt_bf16(const float* __restrict__ src, long n, u16* __restrict__ dst) {
  for (long idx = (long)VB * 256 + VT; idx < n / 8; idx += (long)NVB * 256) {
    float4 a = reinterpret_cast<const float4*>(src)[idx * 2], b = reinterpret_cast<const float4*>(src)[idx * 2 + 1];
    reinterpret_cast<uint4*>(dst)[idx] = make_uint4(pack2bf(a.x, a.y), pack2bf(a.z, a.w), pack2bf(b.x, b.y), pack2bf(b.z, b.w));
  }
}
DI void cvt_f16(const float* __restrict__ src, long n, _Float16* __restrict__ dst) {
  for (long idx = (long)VB * 256 + VT; idx < n / 8; idx += (long)NVB * 256) {
    float4 a = reinterpret_cast<const float4*>(src)[idx * 2], b = reinterpret_cast<const float4*>(src)[idx * 2 + 1];
    h8 o; o[0] = (_Float16)a.x; o[1] = (_Float16)a.y; o[2] = (_Float16)a.z; o[3] = (_Float16)a.w; o[4] = (_Float16)b.x; o[5] = (_Float16)b.y; o[6] = (_Float16)b.z; o[7] = (_Float16)b.w;
    reinterpret_cast<h8*>(dst)[idx] = o;
  }
}
DI float2 ssm_f(const Params& P, int g, int p, float dt) {
  float ar = P.a_re[g * 64 + p], ai = P.a_im[g * 64 + p];
  float2 lb = cexpf2(ar * dt, ai * dt);
  float nr = lb.x - 1.f, ni = lb.y, den = ar * ar + ai * ai;
  return make_float2((nr * ar + ni * ai) / den, (ni * ar - nr * ai) / den);
}

DI void phase0(const Params& P, char* smem) {
  char* ws = P.ws;
  cvt_bf16(P.x, (long)NTOK * DM, (u16*)(ws + OFF_XB));
  transpose_bf16(P.w_in, 1024, 2048, (u16*)(ws + OFF_WINT));
  transpose_bf16(P.w_glu, 512, 512, (u16*)(ws + OFF_WGT));
  transpose_bf16(P.w_out, 1024, 1024, (u16*)(ws + OFF_WOT));
  transpose_bf16(P.w_q, 1024, 2048, (u16*)(ws + OFF_WQT));
  cvt_bf16(P.subk, 8 * 2 * 128 * 128, (u16*)(ws + OFF_SKB));
  const long gtid = (long)VB * 256 + VT, gstride = (long)NVB * 256;
  {
    u16* Wst = (u16*)(ws + OFF_WST);
    for (long idx = gtid; idx < 32L * 64 * 64; idx += gstride) {
      const int g = (int)(idx >> 12), p = (int)(idx >> 6) & 63, j = (int)idx & 63;
      const float dt = expf(P.log_dt[g]);
      const float ar = P.a_re[g * 64 + p], ai = P.a_im[g * 64 + p];
      const float d = (float)(63 - j);
      const float2 E = cmul(cexpf2(ar * dt * d, ai * dt * d), ssm_f(P, g, p, dt));
      unsigned wr_[8], wi_[8];
#pragma unroll
      for (int q = 0; q < 8; ++q) {
        const float2 v0 = cmul(E, make_float2(P.b_re[(g * 64 + p) * 16 + 2 * q], P.b_im[(g * 64 + p) * 16 + 2 * q]));
        const float2 v1 = cmul(E, make_float2(P.b_re[(g * 64 + p) * 16 + 2 * q + 1], P.b_im[(g * 64 + p) * 16 + 2 * q + 1]));
        wr_[q] = pack2bf(v0.x, v1.x); wi_[q] = pack2bf(v0.y, v1.y);
      }
      uint4* dr = reinterpret_cast<uint4*>(Wst + ((long)g * 128 + 2 * p) * 1024 + j * 16);
      uint4* di = reinterpret_cast<uint4*>(Wst + ((long)g * 128 + 2 * p + 1) * 1024 + j * 16);
      dr[0] = make_uint4(wr_[0], wr_[1], wr_[2], wr_[3]); dr[1] = make_uint4(wr_[4], wr_[5], wr_[6], wr_[7]);
      di[0] = make_uint4(wi_[0], wi_[1], wi_[2], wi_[3]); di[1] = make_uint4(wi_[4], wi_[5], wi_[6], wi_[7]);
    }
  }
  {
    u16* Wy = (u16*)(ws + OFF_WY);
    for (long idx = gtid; idx < 32L * 64 * 64; idx += gstride) {
      const int g = (int)(idx >> 12), i = (int)(idx >> 6) & 63, p = (int)idx & 63;
      const float dt = expf(P.log_dt[g]);
      const float ar = P.a_re[g * 64 + p], ai = P.a_im[g * 64 + p];
      const float d = (float)(i + 1);
      const float2 E = cexpf2(ar * dt * d, ai * dt * d);
#pragma unroll
      for (int h = 0; h < 16; ++h) {
        const float2 z = cmul(make_float2(P.c_re[(g * 16 + h) * 64 + p], P.c_im[(g * 16 + h) * 64 + p]), E);
        *reinterpret_cast<unsigned*>(Wy + ((long)g * 1024 + i * 16 + h) * UGLD + 1024 + 2 * p) = pack2bf(z.x, -z.y);
      }
    }
  }
  {
    float* Ktab = (float*)(ws + OFF_KTAB);
    float2* Es = (float2*)smem;
    for (int item0 = RBLK * 2; item0 < 32 * 64; item0 += RGRID * 2) {
      const int item = item0 + VHALF;
      int g = item >> 6, d = item & 63, tid = VT;
      if (tid < 64) {
        float dt = expf(P.log_dt[g]);
        float ar = P.a_re[g * 64 + tid], ai = P.a_im[g * 64 + tid];
        Es[tid] = cmul(cexpf2(ar * dt * (float)d, ai * dt * (float)d), ssm_f(P, g, tid, dt));
      }
      __syncthreads();
      int h = tid >> 4, hp = tid & 15;
      float s = 0.f;
      for (int p = 0; p < 64; ++p) {
        float2 T = cmul(Es[p], make_float2(P.b_re[(g * 64 + p) * 16 + hp], P.b_im[(g * 64 + p) * 16 + hp]));
        s += P.c_re[(g * 16 + h) * 64 + p] * T.x - P.c_im[(g * 16 + h) * 64 + p] * T.y;
      }
      Ktab[((g * 64 + d) * 16 + h) * 16 + hp] = s;
      __syncthreads();
    }
  }
  {
    int* gcount = (int*)(ws + OFF_GCOUNT);
    for (long idx = gtid; idx < 1024; idx += gstride) gcount[idx] = 0;
  }
}

DI void phase1(const Params& P, char* smem) {
  char* ws = P.ws;
  const u16* xb = (const u16*)(ws + OFF_XB);
  const u16* WinT = (const u16*)(ws + OFF_WINT);
  u16* UG = (u16*)(ws + OFF_UG); u16* Qb = (u16*)(ws + OFF_QB); u16* Kb = (u16*)(ws + OFF_KB); u16* Vt = (u16*)(ws + OFF_VT);
  for (int q = RBLK >> 3; q < 128; q += RGRID >> 3) {
    const int brow = q * 256, bcol = (RBLK & 7) * 256;
    gemm_tile256(xb + (long)brow * 1024, 1024, WinT + (long)bcol * 1024, 1024, 32, smem, [&](int row, int col0, f32x4 v) {
      const int r = brow + row, c = bcol + col0;
      const uint2 pk = make_uint2(pack2bf(v[0], v[1]), pack2bf(v[2], v[3]));
      if (bcol < 512) {
        const int g = c >> 4, hp = c & 15, m = r >> 6, j = r & 63;
        *reinterpret_cast<uint2*>(UG + ((long)g * 512 + m) * UGLD + j * 16 + hp) = pk;
      } else if (bcol < 1024) {
        *reinterpret_cast<uint2*>(Qb + (long)r * 512 + (c - 512)) = pk;
      } else if (bcol < 1536) {
        *reinterpret_cast<uint2*>(Kb + (long)r * 512 + (c - 1024)) = pk;
      } else {
        const int hd = c - 1536, b = r >> 13, l = r & 8191;
#pragma unroll
        for (int j = 0; j < 4; ++j) Vt[((long)(b * 512 + hd + j)) * 8192 + l] = f2bf(v[j]);
      }
    });
  }
  {
    const float* Ktab = (const float*)(ws + OFF_KTAB);
    u16* Wy = (u16*)(ws + OFF_WY);
    for (long idx = (long)VB * 256 + VT; idx < 32L * 1024 * 128; idx += (long)NVB * 256) {
      int g = (int)(idx >> 17), n = (int)(idx >> 7) & 1023, k8 = (int)idx & 127, i = n >> 4, h = n & 15, j = k8 >> 1, hp0 = (k8 & 1) * 8;
      if (k8 * 8 >= ((n >> 7) + 1) * 128) continue;
      uint4 o = make_uint4(0, 0, 0, 0);
      if (j <= i) {
        const float4* kp = reinterpret_cast<const float4*>(Ktab + ((g * 64 + (i - j)) * 16 + h) * 16 + hp0);
        float4 a = kp[0], b = kp[1];
        o = make_uint4(pack2bf(a.x, a.y), pack2bf(a.z, a.w), pack2bf(b.x, b.y), pack2bf(b.z, b.w));
      }
      *reinterpret_cast<uint4*>(Wy + ((long)g * 1024 + n) * UGLD + k8 * 8) = o;
    }
  }
}

DI void phase2(const Params& P, char* smem) {
  char* ws = P.ws;
  const u16* UG = (const u16*)(ws + OFF_UG); const u16* Wst = (const u16*)(ws + OFF_WST);
  float* Sloc = (float*)(ws + OFF_SLOC);
  for (int tile0 = RBLK * 2; tile0 < 32 * 4; tile0 += RGRID * 2) {
    const int tile = tile0 + VHALF;
    const int g = tile >> 2, brow = (tile & 3) * 128;
    gemm_tile<true>(UG + ((long)g * 512 + brow) * UGLD, UGLD, Wst + (long)g * 128 * 1024, 1024, 0, 16, 0, 0, smem, [&](int row, int col0, f32x4 v) {
      *reinterpret_cast<float4*>(Sloc + ((long)g * 512 + brow + row) * 128 + col0) = make_float4(v[0], v[1], v[2], v[3]);
    });
  }
  const u16* Kb = (const u16*)(ws + OFF_KB);
  float* kmean = (float*)(ws + OFF_KMEAN);
  float* red = (float*)smem;
  for (int item0 = RBLK * 2; item0 < 1024; item0 += RGRID * 2) {
    const int item = item0 + VHALF;
    const int bh = item >> 5, n = item & 31, b = bh >> 3, h = bh & 7, tid = VT, d = tid & 63, part = tid >> 6;
    float s = 0.f;
    for (int kk = 0; kk < 64; ++kk) s += bf2f(Kb[((long)(b * 8192 + n * 256 + part * 64 + kk)) * 512 + h * 64 + d]);
    red[tid] = s;
    __syncthreads();
    if (tid < 64) kmean[(bh * 32 + n) * 64 + tid] = (red[tid] + red[tid + 64] + red[tid + 128] + red[tid + 192]) * (1.f / 256.f);
    __syncthreads();
  }
}

DI void phase3(const Params& P, char* smem) {
  char* ws = P.ws;
  {
    u16* UG = (u16*)(ws + OFF_UG); const float* Sloc = (const float*)(ws + OFF_SLOC);
    for (int id = VB * 256 + VT; id < 8192; id += NVB * 256) {
      const int p = id & 63, b = (id >> 6) & 3, g = id >> 8;
      const float dt = expf(P.log_dt[g]);
      const float ar = P.a_re[g * 64 + p], ai = P.a_im[g * 64 + p];
      const float2 lamT = cexpf2(ar * dt * 64.f, ai * dt * 64.f);
      float2 s = make_float2(0.f, 0.f);
      for (int c0 = 0; c0 < 128; c0 += 16) {
        const long m0 = (long)g * 512 + b * 128 + c0;
        float2 loc[16];
#pragma unroll
        for (int k = 0; k < 16; ++k) loc[k] = *reinterpret_cast<const float2*>(Sloc + (m0 + k) * 128 + 2 * p);
#pragma unroll
        for (int k = 0; k < 16; ++k) {
          *reinterpret_cast<unsigned*>(UG + (m0 + k) * UGLD + 1024 + 2 * p) = pack2bf(s.x, s.y);
          s = cmul(lamT, s); s.x += loc[k].x; s.y += loc[k].y;
        }
      }
    }
  }
  {
    const u16* Qb = (const u16*)(ws + OFF_QB);
    const float* kmean = (const float*)(ws + OFF_KMEAN);
    int* gcount = (int*)(ws + OFF_GCOUNT);
    u16* list = (u16*)(ws + OFF_LIST);
    float* km = (float*)smem;
    int* cnt = (int*)(smem + 31 * 64 * 4);
    int* base = cnt + 32;
    for (int item0 = RBLK * 2; item0 < 1024; item0 += RGRID * 2) {
      const int item = item0 + VHALF;
      const int bh = item >> 5, own = item & 31, b = bh >> 3, h = bh & 7, tid = VT;
      const bool act = own > 0;
      if (act) for (int i = tid; i < own * 64; i += 256) km[i] = kmean[bh * 32 * 64 + i];
      if (tid < 32) cnt[tid] = 0;
      __syncthreads();
      const int l = own * 256 + tid;
      float v0 = -3e38f, v1 = -3e38f, v2 = -3e38f; int n0 = 0, n1 = 0, n2 = 0;
      if (act) {
        const u16* qrow = Qb + ((long)(b * 8192 + l)) * 512 + h * 64;
        float q[64];
#pragma unroll
        for (int c8 = 0; c8 < 8; ++c8) {
          uint4 w = *reinterpret_cast<const uint4*>(qrow + c8 * 8);
          q[c8 * 8 + 0] = __uint_as_float(w.x << 16); q[c8 * 8 + 1] = __uint_as_float(w.x & 0xffff0000u);
          q[c8 * 8 + 2] = __uint_as_float(w.y << 16); q[c8 * 8 + 3] = __uint_as_float(w.y & 0xffff0000u);
          q[c8 * 8 + 4] = __uint_as_float(w.z << 16); q[c8 * 8 + 5] = __uint_as_float(w.z & 0xffff0000u);
          q[c8 * 8 + 6] = __uint_as_float(w.w << 16); q[c8 * 8 + 7] = __uint_as_float(w.w & 0xffff0000u);
        }
        for (int n = 0; n < own; ++n) {
          float sacc = 0.f;
#pragma unroll
          for (int d = 0; d < 64; ++d) sacc += q[d] * km[n * 64 + d];
          if (sacc > v2) {
            if (sacc > v1) { v2 = v1; n2 = n1; if (sacc > v0) { v1 = v0; n1 = n0; v0 = sacc; n0 = n; } else { v1 = sacc; n1 = n; } }
            else { v2 = sacc; n2 = n; }
          }
        }
      }
      const int nsel = own < 3 ? own : 3;
      int p0 = 0, p1 = 0, p2 = 0;
      if (nsel > 0) p0 = atomicAdd(&cnt[n0], 1);
      if (nsel > 1) p1 = atomicAdd(&cnt[n1], 1);
      if (nsel > 2) p2 = atomicAdd(&cnt[n2], 1);
      __syncthreads();
      if (tid < 32) base[tid] = cnt[tid] > 0 ? atomicAdd(&gcount[bh * 32 + tid], cnt[tid]) : 0;
      __syncthreads();
      if (nsel > 0) list[((long)(bh * 32 + n0)) * 8192 + base[n0] + p0] = (u16)((l << 2) | 0);
      if (nsel > 1) list[((long)(bh * 32 + n1)) * 8192 + base[n1] + p1] = (u16)((l << 2) | 1);
      if (nsel > 2) list[((long)(bh * 32 + n2)) * 8192 + base[n2] + p2] = (u16)((l << 2) | 2);
      __syncthreads();
    }
  }
}

DI float xor32_max(float v) { const auto r = __builtin_amdgcn_permlane32_swap(__float_as_uint(v), __float_as_uint(v), false, false); return fmaxf(__uint_as_float(r[0]), __uint_as_float(r[1])); }
DI float xor32_sum(float v) { const auto r = __builtin_amdgcn_permlane32_swap(__float_as_uint(v), __float_as_uint(v), false, false); return __uint_as_float(r[0]) + __uint_as_float(r[1]); }
DI int crow(int i, int hh) { return (i & 3) + 8 * (i >> 2) + 4 * hh; }

struct AttnQ { bf16x8 qf[4]; int lq, slot; bool valid; };
DI AttnQ attn_q(const Params& P, int bh, int n, int t, int lane) {
  char* ws = P.ws;
  const u16* Qb = (const u16*)(ws + OFF_QB);
  const int* gcount = (const int*)(ws + OFF_GCOUNT); const u16* list = (const u16*)(ws + OFF_LIST);
  const int b = bh >> 3, h = bh & 7, r = lane & 31, hh = lane >> 5;
  AttnQ q; q.valid = true;
  if (t < 8) { q.lq = n * 256 + t * 32 + r; q.slot = 3; }
  else {
    const int cnt = gcount[bh * 32 + n], idx = (t - 8) * 32 + r;
    q.valid = idx < cnt;
    const int e = list[((long)(bh * 32 + n)) * 8192 + (q.valid ? idx : 0)];
    q.lq = e >> 2; q.slot = e & 3;
  }
  const u16* qrow = Qb + ((long)(b * 8192 + q.lq)) * 512 + h * 64 + 8 * hh;
#pragma unroll
  for (int s = 0; s < 4; ++s) q.qf[s] = *reinterpret_cast<const bf16x8*>(qrow + 16 * s);
  return q;
}
DI void attn_task(const Params& P, int bh, int n, int t, int lane, const char* Ks, const char* Vs, const AttnQ& aq) {
  char* ws = P.ws;
  u16* Opart = (u16*)(ws + OFF_OPART); float* Lse = (float*)(ws + OFF_LSE);
  const int b = bh >> 3, h = bh & 7, r = lane & 31, hh = lane >> 5;
  const bool own = t < 8;
  const int lq = aq.lq, slot = aq.slot; const bool valid = aq.valid;
  const bf16x8 qf[4] = {aq.qf[0], aq.qf[1], aq.qf[2], aq.qf[3]};
  float m_run = -1e30f, l_run = 0.f;
  f32x16 O0, O1;
#pragma unroll
  for (int i = 0; i < 16; ++i) { O0[i] = 0.f; O1[i] = 0.f; }
  const int nkt = own ? (t + 1) : 8;
  for (int kt = 0; kt < nkt; ++kt) {
    const int kbase = n * 256 + kt * 32;
    const int krow = kt * 32 + r;
    f32x16 S;
#pragma unroll
    for (int i = 0; i < 16; ++i) S[i] = 0.f;
#pragma unroll
    for (int s = 0; s < 4; ++s) {
      const bf16x8 kf = *reinterpret_cast<const bf16x8*>(Ks + krow * 128 + (((2 * s + hh) ^ ((krow >> 1) & 7)) * 16));
      S = __builtin_amdgcn_mfma_f32_32x32x16_bf16(kf, qf[s], S, 0, 0, 0);
    }
    const bool diag = own && (kt == t);
    constexpr float SC2 = 0.125f * 1.4426950408889634f;
    float mx = -1e30f;
#pragma unroll
    for (int i = 0; i < 16; ++i) {
      if (diag && (kbase + crow(i, hh) > lq)) S[i] = -1e30f;
      mx = fmaxf(mx, S[i]);
    }
    mx = xor32_max(mx);
    const float m_new = fmaxf(m_run, mx * SC2);
    const float alpha = __builtin_amdgcn_exp2f(m_run - m_new);
    float rs = 0.f;
#pragma unroll
    for (int i = 0; i < 16; ++i) { float pv = __builtin_amdgcn_exp2f(fmaf(S[i], SC2, -m_new)); S[i] = pv; rs += pv; }
    rs = xor32_sum(rs);
    l_run = l_run * alpha + rs; m_run = m_new;
    if (__ballot(alpha != 1.f)) {
#pragma unroll
      for (int i = 0; i < 16; ++i) { O0[i] *= alpha; O1[i] *= alpha; }
    }
#pragma unroll
    for (int s = 0; s < 2; ++s) {
      const uint4 ppk = make_uint4(pack2bf(S[8 * s], S[8 * s + 1]), pack2bf(S[8 * s + 2], S[8 * s + 3]), pack2bf(S[8 * s + 4], S[8 * s + 5]), pack2bf(S[8 * s + 6], S[8 * s + 7]));
      const bf16x8 pf = __builtin_bit_cast(bf16x8, ppk);
#pragma unroll
      for (int dt = 0; dt < 2; ++dt) {
        const int vrow = dt * 32 + r, vc = kt * 4 + 2 * s, vw = hh * 8;
        const uint2 lo = *reinterpret_cast<const uint2*>(Vs + vrow * 512 + ((vc ^ (vrow & 15)) * 16) + vw);
        const uint2 hi = *reinterpret_cast<const uint2*>(Vs + vrow * 512 + (((vc + 1) ^ (vrow & 15)) * 16) + vw);
        const uint4 vv = make_uint4(lo.x, lo.y, hi.x, hi.y);
        if (dt == 0) O0 = __builtin_amdgcn_mfma_f32_32x32x16_bf16(__builtin_bit_cast(bf16x8, vv), pf, O0, 0, 0, 0);
        else O1 = __builtin_amdgcn_mfma_f32_32x32x16_bf16(__builtin_bit_cast(bf16x8, vv), pf, O1, 0, 0, 0);
      }
    }
  }
  if (valid) {
    const float inv = 1.f / l_run;
    const long rowid = ((long)(b * 8192 + lq) * 8 + h) * 4 + slot;
    u16* op = Opart + rowid * 64;
#pragma unroll
    for (int gq = 0; gq < 4; ++gq) {
      *reinterpret_cast<uint2*>(op + 8 * gq + 4 * hh) = make_uint2(pack2bf(O0[4 * gq] * inv, O0[4 * gq + 1] * inv), pack2bf(O0[4 * gq + 2] * inv, O0[4 * gq + 3] * inv));
      *reinterpret_cast<uint2*>(op + 32 + 8 * gq + 4 * hh) = make_uint2(pack2bf(O1[4 * gq] * inv, O1[4 * gq + 1] * inv), pack2bf(O1[4 * gq + 2] * inv, O1[4 * gq + 3] * inv));
    }
    if (hh == 0) Lse[rowid] = (m_run + __log2f(l_run)) * 0.6931471805599453f;
  }
}

DI void phase4(const Params& P, char* smem) {
  char* ws = P.ws;
  const u16* UG = (const u16*)(ws + OFF_UG); const u16* Wy = (const u16*)(ws + OFF_WY);
  u16* Yb = (u16*)(ws + OFF_YB);
  TILE_LOOP(tile, 32 * 4 * 8, 8) {
    const int trow = tile >> 3, g = (trow >> 5) * 8 + (tile & 7), brow = (trow & 3) * 128, cidx = (trow >> 2) & 7, bcol = ((trow & 64) ? 7 - cidx : cidx) * 128;
    gemm_tile<true>(UG + ((long)g * 512 + brow) * UGLD, UGLD, Wy + ((long)g * 1024 + bcol) * UGLD, UGLD, 0, (bcol + 128) / 64, 16, 18, smem, [&](int row, int col0, f32x4 v) {
      const int n = bcol + col0, i = n >> 4, h = n & 15, m = brow + row;
      const float4 dsk = *reinterpret_cast<const float4*>(P.dsk + g * 16 + h);
      const uint2 uu = *reinterpret_cast<const uint2*>(UG + ((long)g * 512 + m) * UGLD + n);
      const float y0 = gelu_t(v[0] + dsk.x * __uint_as_float(uu.x << 16)), y1 = gelu_t(v[1] + dsk.y * __uint_as_float(uu.x & 0xffff0000u));
      const float y2 = gelu_t(v[2] + dsk.z * __uint_as_float(uu.y << 16)), y3 = gelu_t(v[3] + dsk.w * __uint_as_float(uu.y & 0xffff0000u));
      *reinterpret_cast<uint2*>(Yb + ((long)m * 64 + i) * 512 + g * 16 + h) = make_uint2(pack2bf(y0, y1), pack2bf(y2, y3));
    });
  }
  const int wid = VT >> 6, lane = VT & 63, tid = VT;
  const int* gcount = (const int*)(ws + OFF_GCOUNT);
  const u16* Kb = (const u16*)(ws + OFF_KB); const u16* Vt = (const u16*)(ws + OFF_VT);
  char* Ks = smem; char* Vs = smem + 32768;
  int* pre = (int*)(smem + 32768 + 33792);
  int* part = pre + 1032;
  __syncthreads();
  {
    if (tid < 32) { int s = 0; for (int k = 0; k < 32; ++k) s += (4 + ((gcount[tid * 32 + k] + 31) >> 5) + 7) >> 3; part[tid + 1] = s; }
    __syncthreads();
    if (tid == 0) { part[0] = 0; for (int k = 1; k <= 32; ++k) part[k] += part[k - 1]; }
    __syncthreads();
    if (tid < 32) { int s = part[tid]; for (int k = 0; k < 32; ++k) { pre[tid * 32 + k] = s; s += (4 + ((gcount[tid * 32 + k] + 31) >> 5) + 7) >> 3; } }
    if (tid == 0) pre[1024] = part[32];
    __syncthreads();
  }
  const int total = pre[1024];
  const int per = (total + 7) >> 3, slot = (RBLK >> 3) * 2 + VHALF, nslot = (RGRID >> 3) * 2;
  for (int k0 = 0; k0 < per; k0 += nslot) {
    const int kk = k0 + slot, it_ = (RBLK & 7) * per + kk;
    const bool act = kk < per && it_ < total;
    const int it = act ? it_ : 0;
    int lo = 0, hi = 1024;
    while (hi - lo > 1) { const int mid = (lo + hi) >> 1; if (pre[mid] <= it) lo = mid; else hi = mid; }
    const int bh = lo >> 5, n = lo & 31, b = bh >> 3, h = bh & 7;
    const int ntask = 4 + ((gcount[lo] + 31) >> 5);
    const int task = (it - pre[lo]) * 8 + wid;
#pragma unroll
    for (int i = 0; i < 8; ++i) {
      const int q = i * 256 + tid, krow_ = q >> 3, kc = (q & 7) ^ ((krow_ >> 1) & 7), vrow_ = q >> 5, vcc = (q & 31) ^ (vrow_ & 15);
      __builtin_amdgcn_global_load_lds((const unsigned*)(Kb + ((long)(b * 8192 + n * 256 + krow_)) * 512 + h * 64 + kc * 8), (__attribute__((address_space(3))) unsigned*)(Ks + q * 16), 16, 0, 0);
      __builtin_amdgcn_global_load_lds((const unsigned*)(Vt + ((long)(bh * 64 + vrow_)) * 8192 + n * 256 + vcc * 8), (__attribute__((address_space(3))) unsigned*)(Vs + q * 16), 16, 0, 0);
    }
    const bool run = act && task < ntask;
    const int t0 = task < 4 ? task : task - 4 + 8;
    const AttnQ q0 = attn_q(P, bh, n, run ? t0 : 0, lane);
    asm volatile("s_waitcnt vmcnt(0)" ::: "memory");
    __syncthreads();
    if (run) {
      attn_task(P, bh, n, t0, lane, Ks, Vs, q0);
      if (task < 4) attn_task(P, bh, n, 7 - task, lane, Ks, Vs, attn_q(P, bh, n, 7 - task, lane));
    }
    if (act && task + 4 < ntask) attn_task(P, bh, n, task + 8, lane, Ks, Vs, attn_q(P, bh, n, task + 8, lane));
    __syncthreads();
  }
}

DI void phase5(const Params& P, char* smem) {
  char* ws = P.ws;
  const u16* Yb = (const u16*)(ws + OFF_YB); const u16* WgT = (const u16*)(ws + OFF_WGT);
  u16* cat = (u16*)(ws + OFF_CAT);
  TILE_LOOP(tile, 256 * 4, 4) {
    const int brow = (tile >> 2) * 128, bcol = (tile & 3) * 128;
    gemm_tile<true>(Yb + (long)brow * 512, 512, WgT + (long)bcol * 512, 512, 0, 8, 0, 0, smem, [&](int row, int col0, f32x4 v) {
      const long r = brow + row; const int c = bcol + col0;
      const uint2 yy = *reinterpret_cast<const uint2*>(Yb + r * 512 + c);
      const float o0 = __uint_as_float(yy.x << 16) / (1.f + __expf(-v[0])), o1 = __uint_as_float(yy.x & 0xffff0000u) / (1.f + __expf(-v[1]));
      const float o2 = __uint_as_float(yy.y << 16) / (1.f + __expf(-v[2])), o3 = __uint_as_float(yy.y & 0xffff0000u) / (1.f + __expf(-v[3]));
      *reinterpret_cast<uint2*>(cat + r * 1024 + c) = make_uint2(pack2bf(o0, o1), pack2bf(o2, o3));
    });
  }
  const u16* Opart = (const u16*)(ws + OFF_OPART); const float* Lse = (const float*)(ws + OFF_LSE);
  for (long idx = (long)VB * 256 + VT; idx < (long)NTOK * 64; idx += (long)NVB * 256) {
    const int dg = (int)idx & 7, h = (int)(idx >> 3) & 7; const long tok = idx >> 6;
    const int l = (int)(tok & 8191); const int ownb = l >> 8; const int nv = ownb < 3 ? ownb : 3;
    const long base = (tok * 8 + h) * 4;
    float ls[4]; float mx = -3e38f;
#pragma unroll
    for (int s = 0; s < 4; ++s) { const bool ok = (s == 3) || (s < nv); ls[s] = ok ? Lse[base + s] : -3e38f; mx = fmaxf(mx, ls[s]); }
    float acc[8]; float wsum = 0.f;
#pragma unroll
    for (int k = 0; k < 8; ++k) acc[k] = 0.f;
#pragma unroll
    for (int s = 0; s < 4; ++s) {
      const bool ok = (s == 3) || (s < nv);
      if (ok) {
        const float w = __expf(ls[s] - mx); wsum += w;
        uint4 o = *reinterpret_cast<const uint4*>(Opart + (base + s) * 64 + dg * 8);
        acc[0] += w * __uint_as_float(o.x << 16); acc[1] += w * __uint_as_float(o.x & 0xffff0000u);
        acc[2] += w * __uint_as_float(o.y << 16); acc[3] += w * __uint_as_float(o.y & 0xffff0000u);
        acc[4] += w * __uint_as_float(o.z << 16); acc[5] += w * __uint_as_float(o.z & 0xffff0000u);
        acc[6] += w * __uint_as_float(o.w << 16); acc[7] += w * __uint_as_float(o.w & 0xffff0000u);
      }
    }
    const float inv = 1.f / wsum;
    *reinterpret_cast<uint4*>(cat + tok * 1024 + 512 + h * 64 + dg * 8) =
        make_uint4(pack2bf(acc[0] * inv, acc[1] * inv), pack2bf(acc[2] * inv, acc[3] * inv), pack2bf(acc[4] * inv, acc[5] * inv), pack2bf(acc[6] * inv, acc[7] * inv));
  }
}

DI void phase6(const Params& P, char* smem) {
  char* ws = P.ws;
  const u16* cat = (const u16*)(ws + OFF_CAT); const u16* WoT = (const u16*)(ws + OFF_WOT);
  float* Z1 = (float*)(ws + OFF_Z1);
  for (int q = RBLK >> 3; q < 64; q += RGRID >> 3) {
    const int brow = (q * 2 + ((RBLK & 7) >> 2)) * 256, bcol = (RBLK & 3) * 256;
    gemm_tile256(cat + (long)brow * 1024, 1024, WoT + (long)bcol * 1024, 1024, 32, smem, [&](int row, int col0, f32x4 v) {
      const long o = (long)(brow + row) * 1024 + bcol + col0;
      const float4 xs = *reinterpret_cast<const float4*>(P.x + o);
      *reinterpret_cast<float4*>(Z1 + o) = make_float4(ALPHA * xs.x + v[0], ALPHA * xs.y + v[1], ALPHA * xs.z + v[2], ALPHA * xs.w + v[3]);
    });
  }
}

DI void phase7(const Params& P, char* smem) {
  char* ws = P.ws;
  const float* Z1 = (const float*)(ws + OFF_Z1);
  _Float16* h1h = (_Float16*)(ws + OFF_H1H); u16* h1b = (u16*)(ws + OFF_H1B);
  const int wid = VT >> 6, lane = VT & 63;
  for (int row = VB * 4 + wid; row < NTOK; row += NVB * 4) {
    float4 z[4]; float s = 0.f;
#pragma unroll
    for (int k = 0; k < 4; ++k) { z[k] = *reinterpret_cast<const float4*>(Z1 + (long)row * 1024 + k * 256 + lane * 4); s += z[k].x + z[k].y + z[k].z + z[k].w; }
    const float mu = wave_sum(s) * (1.f / 1024.f);
    float q = 0.f;
#pragma unroll
    for (int k = 0; k < 4; ++k) { float a = z[k].x - mu, b = z[k].y - mu, c = z[k].z - mu, d = z[k].w - mu; q += a * a + b * b + c * c + d * d; }
    const float rstd = rsqrtf(wave_sum(q) * (1.f / 1024.f) + 1e-5f);
#pragma unroll
    for (int k = 0; k < 4; ++k) {
      const int c0 = k * 256 + lane * 4;
      const float4 gg = *reinterpret_cast<const float4*>(P.ln1g + c0), bb = *reinterpret_cast<const float4*>(P.ln1b + c0);
      const float y0 = (z[k].x - mu) * rstd * gg.x + bb.x, y1 = (z[k].y - mu) * rstd * gg.y + bb.y, y2 = (z[k].z - mu) * rstd * gg.z + bb.z, y3 = (z[k].w - mu) * rstd * gg.w + bb.w;
      typedef _Float16 h4 __attribute__((ext_vector_type(4)));
      h4 hv; hv[0] = (_Float16)y0; hv[1] = (_Float16)y1; hv[2] = (_Float16)y2; hv[3] = (_Float16)y3;
      *reinterpret_cast<h4*>(h1h + (long)row * 1024 + c0) = hv;
      *reinterpret_cast<uint2*>(h1b + (long)row * 1024 + c0) = make_uint2(pack2bf(y0, y1), pack2bf(y2, y3));
      z[k] = make_float4(y0, y1, y2, y3);
    }
    float am = 0.f;
#pragma unroll
    for (int k = 0; k < 4; ++k) am = fmaxf(am, fmaxf(fmaxf(fabsf(z[k].x), fabsf(z[k].y)), fmaxf(fabsf(z[k].z), fabsf(z[k].w))));
    am = wave_max(am);
    const float xinv = am > 0.f ? 127.f / am : 0.f;
#pragma unroll
    for (int k = 0; k < 4; ++k) {
      const unsigned pk = ((unsigned)((int)rintf(z[k].x * xinv) & 0xff)) | ((unsigned)((int)rintf(z[k].y * xinv) & 0xff) << 8) |
                          ((unsigned)((int)rintf(z[k].z * xinv) & 0xff) << 16) | ((unsigned)((int)rintf(z[k].w * xinv) & 0xff) << 24);
      *reinterpret_cast<unsigned*>(ws + OFF_XQ + (long)row * 1024 + k * 256 + lane * 4) = pk;
    }
    if (lane == 0) reinterpret_cast<float*>(ws + OFF_SX)[row] = am * (1.f / 127.f);
  }
  for (int row = VB * 4 + wid; row < 2 * 16384; row += NVB * 4) {
    const bool isv = row >= 16384; const int e = row & 16383;
    const float* src = (isv ? P.pv : P.pu) + (long)e * 1024 + lane * 16;
    float f[16];
#pragma unroll
    for (int k = 0; k < 4; ++k) { const float4 a = reinterpret_cast<const float4*>(src)[k]; f[4 * k] = a.x; f[4 * k + 1] = a.y; f[4 * k + 2] = a.z; f[4 * k + 3] = a.w; }
    float am = 0.f;
#pragma unroll
    for (int k = 0; k < 16; ++k) am = fmaxf(am, fabsf(f[k]));
    am = wave_max(am);
    const float inv = am > 0.f ? 127.f / am : 0.f;
    unsigned w[4];
#pragma unroll
    for (int k = 0; k < 4; ++k) {
      unsigned pk = 0;
#pragma unroll
      for (int b = 0; b < 4; ++b) { int q = (int)rintf(f[4 * k + b] * inv); q = q > 127 ? 127 : (q < -127 ? -127 : q); pk |= ((unsigned)((isv ? q + 128 : q) & 0xff)) << (8 * b); }
      w[k] = pk;
    }
    *reinterpret_cast<uint4*>(ws + (isv ? OFF_VQ + ((long)(lane >> 3) * 16384 + e) * 128 + (lane & 7) * 16 : OFF_UQ + (long)e * 1024 + lane * 16)) = make_uint4(w[0], w[1], w[2], w[3]);
    if (lane == 0) reinterpret_cast<float*>(ws + (isv ? OFF_VS : OFF_US))[e] = am * (1.f / 127.f);
  }
}

DI void phase8(const Params& P, char* smem) {
  char* ws = P.ws;
  const u16* h1b = (const u16*)(ws + OFF_H1B); const u16* WqT = (const u16*)(ws + OFF_WQT);
  u16* Qp = (u16*)(ws + OFF_QP);
  for (int q = RBLK >> 3; q < 128; q += RGRID >> 3) {
    const int brow = q * 256, bcol = (RBLK & 7) * 256;
    gemm_tile256(h1b + (long)brow * 1024, 1024, WqT + (long)bcol * 1024, 1024, 32, smem, [&](int row, int col0, f32x4 v) {
      *reinterpret_cast<uint2*>(Qp + (long)(brow + row) * 2048 + bcol + col0) = make_uint2(pack2bf(v[0], v[1]), pack2bf(v[2], v[3]));
    });
  }
}

DI void phase9(const Params& P, char* smem) {
  char* ws = P.ws;
  const u16* Qp = (const u16*)(ws + OFF_QP); const u16* SKb = (const u16*)(ws + OFF_SKB);
  _Float16* ST = (_Float16*)(ws + OFF_ST);
  TILE_LOOP(tile, 256 * 16, 16) {
    const int brow = (tile >> 4) * 128, hc = tile & 15;
    gemm_tile<false>(Qp + (long)brow * 2048 + hc * 128, 2048, SKb + (long)hc * 128 * 128, 128, 0, 2, 0, 0, smem, [&](int row0, int col, f32x4 v) {
      typedef _Float16 h4 __attribute__((ext_vector_type(4)));
      h4 hv; hv[0] = (_Float16)v[0]; hv[1] = (_Float16)v[1]; hv[2] = (_Float16)v[2]; hv[3] = (_Float16)v[3];
      *reinterpret_cast<h4*>(ST + ((long)(hc * 128 + col)) * NTOK + brow + row0) = hv;
    });
  }
}

DI unsigned umax_(unsigned a, unsigned b) { return a > b ? a : b; }
DI unsigned umin_(unsigned a, unsigned b) { return a < b ? a : b; }
#define CE(a, b) { const unsigned hi_ = umax_(a, b), lo_ = umin_(a, b); a = hi_; b = lo_; }
#define SORT16(A) CE(A[0],A[1]) CE(A[2],A[3]) CE(A[4],A[5]) CE(A[6],A[7]) CE(A[8],A[9]) CE(A[10],A[11]) CE(A[12],A[13]) CE(A[14],A[15]) CE(A[0],A[2]) CE(A[1],A[3]) CE(A[4],A[6]) CE(A[5],A[7]) CE(A[8],A[10]) CE(A[9],A[11]) CE(A[12],A[14]) CE(A[13],A[15]) CE(A[1],A[2]) CE(A[5],A[6]) CE(A[9],A[10]) CE(A[13],A[14]) CE(A[0],A[4]) CE(A[1],A[5]) CE(A[2],A[6]) CE(A[3],A[7]) CE(A[8],A[12]) CE(A[9],A[13]) CE(A[10],A[14]) CE(A[11],A[15]) CE(A[2],A[4]) CE(A[3],A[5]) CE(A[10],A[12]) CE(A[11],A[13]) CE(A[1],A[2]) CE(A[3],A[4]) CE(A[5],A[6]) CE(A[9],A[10]) CE(A[11],A[12]) CE(A[13],A[14]) CE(A[0],A[8]) CE(A[1],A[9]) CE(A[2],A[10]) CE(A[3],A[11]) CE(A[4],A[12]) CE(A[5],A[13]) CE(A[6],A[14]) CE(A[7],A[15]) CE(A[4],A[8]) CE(A[5],A[9]) CE(A[6],A[10]) CE(A[7],A[11]) CE(A[2],A[4]) CE(A[3],A[5]) CE(A[6],A[8]) CE(A[7],A[9]) CE(A[10],A[12]) CE(A[11],A[13]) CE(A[1],A[2]) CE(A[3],A[4]) CE(A[5],A[6]) CE(A[7],A[8]) CE(A[9],A[10]) CE(A[11],A[12]) CE(A[13],A[14])
#define MERGE16(R,G) R[0]=umax_(R[0],G[15]); R[1]=umax_(R[1],G[14]); R[2]=umax_(R[2],G[13]); R[3]=umax_(R[3],G[12]); R[4]=umax_(R[4],G[11]); R[5]=umax_(R[5],G[10]); R[6]=umax_(R[6],G[9]); R[7]=umax_(R[7],G[8]); R[8]=umax_(R[8],G[7]); R[9]=umax_(R[9],G[6]); R[10]=umax_(R[10],G[5]); R[11]=umax_(R[11],G[4]); R[12]=umax_(R[12],G[3]); R[13]=umax_(R[13],G[2]); R[14]=umax_(R[14],G[1]); R[15]=umax_(R[15],G[0]); CE(R[0],R[8]) CE(R[1],R[9]) CE(R[2],R[10]) CE(R[3],R[11]) CE(R[4],R[12]) CE(R[5],R[13]) CE(R[6],R[14]) CE(R[7],R[15]) CE(R[0],R[4]) CE(R[1],R[5]) CE(R[2],R[6]) CE(R[3],R[7]) CE(R[8],R[12]) CE(R[9],R[13]) CE(R[10],R[14]) CE(R[11],R[15]) CE(R[0],R[2]) CE(R[1],R[3]) CE(R[4],R[6]) CE(R[5],R[7]) CE(R[8],R[10]) CE(R[9],R[11]) CE(R[12],R[14]) CE(R[13],R[15]) CE(R[0],R[1]) CE(R[2],R[3]) CE(R[4],R[5]) CE(R[6],R[7]) CE(R[8],R[9]) CE(R[10],R[11]) CE(R[12],R[13]) CE(R[14],R[15])

DI void topk_half(const _Float16* __restrict__ sp, unsigned (&R)[16]) {
#pragma unroll
  for (int e = 0; e < 16; ++e) R[e] = 0u;
#pragma unroll 1
  for (int gi = 0; gi < 8; ++gi) {
    unsigned Gk[16];
#pragma unroll
    for (int e = 0; e < 16; ++e) {
      const int n = gi * 16 + e;
      const unsigned bits = __builtin_bit_cast(unsigned short, sp[(long)n * NTOK]);
      const unsigned o = (bits & 0x8000u) ? (~bits & 0xffffu) : (bits | 0x8000u);
      Gk[e] = (o << 16) | (unsigned)(127 - n);
    }
    SORT16(Gk)
    MERGE16(R, Gk)
  }
}
DI float key_val16(unsigned k) { const unsigned o = k >> 16; const unsigned short b = (unsigned short)((o & 0x8000u) ? (o & 0x7fffu) : (~o & 0xffffu)); return (float)__builtin_bit_cast(_Float16, b); }
DI unsigned candkey(float s, int pos) { const unsigned b = __float_as_uint(s); const unsigned o = (b >> 31) ? ~b : (b ^ 0x80000000u); return (o & 0xffffff00u) | (unsigned)(255 - pos); }
DI unsigned lut4(const unsigned (&W)[4], int a) { const int j = a >> 2; const unsigned w = j == 0 ? W[0] : (j == 1 ? W[1] : (j == 2 ? W[2] : W[3])); return (w >> ((a & 3) * 8)) & 0xffu; }

DI void phase10(const Params& P, char* smem) {
  char* ws = P.ws;
  const _Float16* ST = (const _Float16*)(ws + OFF_ST);
  int* Eidx = (int*)(ws + OFF_EIDX); float* G = (float*)(ws + OFF_G);
  for (long id = (long)VB * 256 + VT; id < (long)NTOK * 8; id += (long)NVB * 256) {
    const int t = (int)(id & (NTOK - 1)), h = (int)(id >> 15);
    unsigned R1[16], R2[16];
    topk_half(ST + ((long)(h * 2 + 0) * 128) * NTOK + t, R1);
    topk_half(ST + ((long)(h * 2 + 1) * 128) * NTOK + t, R2);
    float v1[16], v2[16]; unsigned W1[4] = {0u, 0u, 0u, 0u}, W2[4] = {0u, 0u, 0u, 0u};
#pragma unroll
    for (int k = 0; k < 16; ++k) {
      v1[k] = key_val16(R1[k]); v2[k] = key_val16(R2[k]);
      W1[k >> 2] |= (127u - (R1[k] & 127u)) << ((k & 3) * 8);
      W2[k >> 2] |= (127u - (R2[k] & 127u)) << ((k & 3) * 8);
    }
    unsigned C0[16], C1[16], C2[16], C3[16];
    C0[0] = candkey(v1[0] + v2[0], 0);
    C0[1] = candkey(v1[0] + v2[1], 1);
    C0[2] = candkey(v1[0] + v2[2], 2);
    C0[3] = candkey(v1[0] + v2[3], 3);
    C0[4] = candkey(v1[0] + v2[4], 4);
    C0[5] = candkey(v1[0] + v2[5], 5);
    C0[6] = candkey(v1[0] + v2[6], 6);
    C0[7] = candkey(v1[0] + v2[7], 7);
    C0[8] = candkey(v1[0] + v2[8], 8);
    C0[9] = candkey(v1[0] + v2[9], 9);
    C0[10] = candkey(v1[0] + v2[10], 10);
    C0[11] = candkey(v1[0] + v2[11], 11);
    C0[12] = candkey(v1[0] + v2[12], 12);
    C0[13] = candkey(v1[0] + v2[13], 13);
    C0[14] = candkey(v1[0] + v2[14], 14);
    C0[15] = candkey(v1[0] + v2[15], 15);
    C1[0] = candkey(v1[1] + v2[0], 16);
    C1[1] = candkey(v1[1] + v2[1], 17);
    C1[2] = candkey(v1[1] + v2[2], 18);
    C1[3] = candkey(v1[1] + v2[3], 19);
    C1[4] = candkey(v1[1] + v2[4], 20);
    C1[5] = candkey(v1[1] + v2[5], 21);
    C1[6] = candkey(v1[1] + v2[6], 22);
    C1[7] = candkey(v1[1] + v2[7], 23);
    C1[8] = candkey(v1[2] + v2[0], 32);
    C1[9] = candkey(v1[2] + v2[1], 33);
    C1[10] = candkey(v1[2] + v2[2], 34);
    C1[11] = candkey(v1[2] + v2[3], 35);
    C1[12] = candkey(v1[2] + v2[4], 36);
    C1[13] = candkey(v1[3] + v2[0], 48);
    C1[14] = candkey(v1[3] + v2[1], 49);
    C1[15] = candkey(v1[3] + v2[2], 50);
    C2[0] = candkey(v1[3] + v2[3], 51);
    C2[1] = candkey(v1[4] + v2[0], 64);
    C2[2] = candkey(v1[4] + v2[1], 65);
    C2[3] = candkey(v1[4] + v2[2], 66);
    C2[4] = candkey(v1[5] + v2[0], 80);
    C2[5] = candkey(v1[5] + v2[1], 81);
    C2[6] = candkey(v1[6] + v2[0], 96);
    C2[7] = candkey(v1[6] + v2[1], 97);
    C2[8] = candkey(v1[7] + v2[0], 112);
    C2[9] = candkey(v1[7] + v2[1], 113);
    C2[10] = candkey(v1[8] + v2[0], 128);
    C2[11] = candkey(v1[9] + v2[0], 144);
    C2[12] = candkey(v1[10] + v2[0], 160);
    C2[13] = candkey(v1[11] + v2[0], 176);
    C2[14] = candkey(v1[12] + v2[0], 192);
    C2[15] = candkey(v1[13] + v2[0], 208);
    C3[0] = candkey(v1[14] + v2[0], 224);
    C3[1] = candkey(v1[15] + v2[0], 240);
    C3[2] = 0u;
    C3[3] = 0u;
    C3[4] = 0u;
    C3[5] = 0u;
    C3[6] = 0u;
    C3[7] = 0u;
    C3[8] = 0u;
    C3[9] = 0u;
    C3[10] = 0u;
    C3[11] = 0u;
    C3[12] = 0u;
    C3[13] = 0u;
    C3[14] = 0u;
    C3[15] = 0u;
    SORT16(C1) SORT16(C2) SORT16(C3)
    MERGE16(C0, C1) MERGE16(C0, C2) MERGE16(C0, C3)
    float e[16]; int te[16]; float sum = 0.f;
    const float tv0 = [&]() { const unsigned o = C0[0] & 0xffffff00u; return __uint_as_float((o >> 31) ? (o ^ 0x80000000u) : ~o); }();
#pragma unroll
    for (int k = 0; k < 16; ++k) {
      const unsigned key = C0[k]; const unsigned o = key & 0xffffff00u;
      const float val = __uint_as_float((o >> 31) ? (o ^ 0x80000000u) : ~o);
      const int pos = 255 - (int)(key & 255u);
      te[k] = (int)(lut4(W1, pos >> 4) * 128u + lut4(W2, pos & 15));
      e[k] = __expf(val - tv0); sum += e[k];
    }
    const float inv = 1.f / sum;
    int4* ep = reinterpret_cast<int4*>(Eidx + ((long)t * 8 + h) * 16);
    float4* gp = reinterpret_cast<float4*>(G + ((long)t * 8 + h) * 16);
#pragma unroll
    for (int k = 0; k < 4; ++k) {
      ep[k] = make_int4(te[4 * k], te[4 * k + 1], te[4 * k + 2], te[4 * k + 3]);
      gp[k] = make_float4(e[4 * k] * inv, e[4 * k + 1] * inv, e[4 * k + 2] * inv, e[4 * k + 3] * inv);
    }
  }
}

DI int dpp_row_sum_i(int v) {
  v += __builtin_amdgcn_update_dpp(0, v, 0xB1, 0xF, 0xF, true);
  v += __builtin_amdgcn_update_dpp(0, v, 0x4E, 0xF, 0xF, true);
  v += __builtin_amdgcn_update_dpp(0, v, 0x141, 0xF, 0xF, true);
  v += __builtin_amdgcn_update_dpp(0, v, 0x140, 0xF, 0xF, true);
  return v;
}
DI int wave_sum_i(int v) { v = dpp_row_sum_i(v); return __builtin_amdgcn_readlane(v, 0) + __builtin_amdgcn_readlane(v, 16) + __builtin_amdgcn_readlane(v, 32) + __builtin_amdgcn_readlane(v, 48); }

DI void phase11a(const Params& P, char* smem_all) {
  char* ws = P.ws;
  const char* Uq = ws + OFF_UQ; const float* Us = (const float*)(ws + OFF_US); const float* Vs = (const float*)(ws + OFF_VS);
  const int* Eidx = (const int*)(ws + OFF_EIDX); const float* G = (const float*)(ws + OFF_G);
  const char* xq = ws + OFF_XQ; const float* sxp = (const float*)(ws + OFF_SX);
  float* W2 = (float*)(ws + OFF_W2); int* E2 = (int*)(ws + OFF_E2);
  const int j = RBLK & 7, lane = RTID & 63, wslot = (RBLK >> 3) * 8 + (RTID >> 6), nw = (RGRID >> 3) * 8;
  const int l16 = lane & 15, rg = lane >> 4;
  uint2* lst = (uint2*)(smem_all + (RTID >> 6) * 1024);
  int nE0 = Eidx[(long)wslot * 128 + lane], nE1 = Eidx[(long)wslot * 128 + 64 + lane];
  float nG0 = G[(long)wslot * 128 + lane], nG1 = G[(long)wslot * 128 + 64 + lane];
  uint4 nx[4];
#pragma unroll
  for (int c = 0; c < 4; ++c) nx[c] = *reinterpret_cast<const uint4*>(xq + (long)wslot * 1024 + (c * 16 + l16) * 16);
  float nsx = sxp[wslot];
  for (int t = wslot; t < NTOK; t += nw) {
    const int E0 = nE0, E1 = nE1; const float G0 = nG0, G1 = nG1, sx = nsx;
    uint4 xr[4];
#pragma unroll
    for (int c = 0; c < 4; ++c) xr[c] = nx[c];
    bool pf = false;
    const int tn = t + nw < NTOK ? t + nw : t;
    if (j == 0) { E2[(long)t * 128 + (lane & 7) * 16 + (lane >> 3)] = E0; E2[(long)t * 128 + (lane & 7) * 16 + 8 + (lane >> 3)] = E1; }
    const bool in0 = (E0 >> 11) == j, in1 = (E1 >> 11) == j;
    const unsigned long long m0 = __ballot(in0), m1 = __ballot(in1);
    const int c0 = __popcll(m0), cnt = c0 + __popcll(m1);
    const int r0 = __builtin_amdgcn_mbcnt_hi((unsigned)(m0 >> 32), __builtin_amdgcn_mbcnt_lo((unsigned)m0, 0u));
    const int r1 = c0 + __builtin_amdgcn_mbcnt_hi((unsigned)(m1 >> 32), __builtin_amdgcn_mbcnt_lo((unsigned)m1, 0u));
    if (in0) lst[r0] = make_uint2((unsigned)E0 | ((unsigned)lane << 14), __float_as_uint(G0));
    if (in1) lst[r1] = make_uint2((unsigned)E1 | ((unsigned)(64 + lane) << 14), __float_as_uint(G1));
    for (int g0 = 0; g0 < cnt; g0 += 24) {
      const int rem = cnt - g0, ng = rem >= 24 ? 6 : (rem + 3) >> 2;
      int el[6], pl[6]; float gl[6];
#pragma unroll
      for (int gi = 0; gi < 6; ++gi) {
        const int idx = g0 + 4 * gi + rg; const bool ok = idx < cnt;
        const uint2 en = lst[ok ? idx : 0];
        el[gi] = ok ? (int)(en.x & 16383u) : 0; pl[gi] = ok ? (int)(en.x >> 14) : -1; gl[gi] = ok ? __uint_as_float(en.y) : 0.f;
      }
      uint4 u[6][4]; float su[6], sv[6];
#pragma unroll
      for (int gi = 0; gi < 6; ++gi) {
        if (gi < ng) {
          const char* rowp = Uq + (long)el[gi] * 1024 + l16 * 16;
#pragma unroll
          for (int c = 0; c < 4; ++c) u[gi][c] = *reinterpret_cast<const uint4*>(rowp + c * 256);
          su[gi] = Us[el[gi]]; sv[gi] = Vs[el[gi]];
        }
      }
      if (!pf) {
        pf = true;
        nE0 = Eidx[(long)tn * 128 + lane]; nE1 = Eidx[(long)tn * 128 + 64 + lane];
        nG0 = G[(long)tn * 128 + lane]; nG1 = G[(long)tn * 128 + 64 + lane];
#pragma unroll
        for (int c = 0; c < 4; ++c) nx[c] = *reinterpret_cast<const uint4*>(xq + (long)tn * 1024 + (c * 16 + l16) * 16);
        nsx = sxp[tn];
      }
#pragma unroll
      for (int gi = 0; gi < 6; ++gi) {
        if (gi < ng) {
          int d = 0;
#pragma unroll
          for (int c = 0; c < 4; ++c) {
            d = __builtin_amdgcn_sdot4((int)u[gi][c].x, (int)xr[c].x, d, false);
            d = __builtin_amdgcn_sdot4((int)u[gi][c].y, (int)xr[c].y, d, false);
            d = __builtin_amdgcn_sdot4((int)u[gi][c].z, (int)xr[c].z, d, false);
            d = __builtin_amdgcn_sdot4((int)u[gi][c].w, (int)xr[c].w, d, false);
          }
          d = dpp_row_sum_i(d);
          const float dot = (float)d * (su[gi] * sx);
          const float w = gl[gi] * gelu_t(dot) * sv[gi];
          const int p = pl[gi];
          if (l16 == 0 && p >= 0) W2[(long)t * 128 + (p & 7) * 16 + (p >> 3)] = w;
        }
      }
    }
    if (!pf) {
      nE0 = Eidx[(long)tn * 128 + lane]; nE1 = Eidx[(long)tn * 128 + 64 + lane];
      nG0 = G[(long)tn * 128 + lane]; nG1 = G[(long)tn * 128 + 64 + lane];
#pragma unroll
      for (int c = 0; c < 4; ++c) nx[c] = *reinterpret_cast<const uint4*>(xq + (long)tn * 1024 + (c * 16 + l16) * 16);
      nsx = sxp[tn];
    }
  }
}

DI float dpp_row_sum_f(float v) {
  v += __int_as_float(__builtin_amdgcn_update_dpp(0, __float_as_int(v), 0xB1, 0xF, 0xF, true));
  v += __int_as_float(__builtin_amdgcn_update_dpp(0, __float_as_int(v), 0x4E, 0xF, 0xF, true));
  v += __int_as_float(__builtin_amdgcn_update_dpp(0, __float_as_int(v), 0x141, 0xF, 0xF, true));
  v += __int_as_float(__builtin_amdgcn_update_dpp(0, __float_as_int(v), 0x140, 0xF, 0xF, true));
  return v;
}
DI void phase11b(const Params& P, char* smem_all) {
  char* ws = P.ws;
  const char* Vq = ws + OFF_VQ;
  const float* W2 = (const float*)(ws + OFF_W2); const int* E2 = (const int*)(ws + OFF_E2);
  _Float16* Zp = (_Float16*)(ws + OFF_ZP);
  const int j = RBLK & 7, lane = RTID & 63, wv = RTID >> 6, wslot = (RBLK >> 3) * 8 + wv, nw = (RGRID >> 3) * 8;
  float* red = (float*)(smem_all + wv * 4096);
  const char* vbase = Vq + (long)j * 16384 * 128 + (lane & 7) * 16;
  const int g8 = lane >> 3;
  int4 en[4]; float4 wn[4];
  auto load_list = [&](int t) {
#pragma unroll
    for (int k = 0; k < 4; ++k) {
      en[k] = *reinterpret_cast<const int4*>(E2 + (long)t * 128 + g8 * 16 + 4 * k);
      wn[k] = *reinterpret_cast<const float4*>(W2 + (long)t * 128 + g8 * 16 + 4 * k);
    }
  };
  auto gather = [&](uint4 (&v)[16], float (&w)[16]) {
#pragma unroll
    for (int k = 0; k < 4; ++k) {
      v[4 * k] = *reinterpret_cast<const uint4*>(vbase + (long)en[k].x * 128); v[4 * k + 1] = *reinterpret_cast<const uint4*>(vbase + (long)en[k].y * 128);
      v[4 * k + 2] = *reinterpret_cast<const uint4*>(vbase + (long)en[k].z * 128); v[4 * k + 3] = *reinterpret_cast<const uint4*>(vbase + (long)en[k].w * 128);
      w[4 * k] = wn[k].x; w[4 * k + 1] = wn[k].y; w[4 * k + 2] = wn[k].z; w[4 * k + 3] = wn[k].w;
    }
  };
  auto reduce_store = [&](const uint4 (&v)[16], const float (&w)[16], int t) {
    typedef float f2 __attribute__((ext_vector_type(2)));
    f2 acc[8]; float wl = 0.f;
#pragma unroll
    for (int k = 0; k < 8; ++k) acc[k] = f2{0.f, 0.f};
#pragma unroll
    for (int r = 0; r < 16; ++r) {
      wl += w[r];
      const f2 w2 = f2{w[r], w[r]};
      const unsigned vw[4] = {v[r].x, v[r].y, v[r].z, v[r].w};
#pragma unroll
      for (int k = 0; k < 4; ++k) {
        acc[2 * k + 0] = __builtin_elementwise_fma(w2, f2{(float)(vw[k] & 0xffu), (float)((vw[k] >> 8) & 0xffu)}, acc[2 * k + 0]);
        acc[2 * k + 1] = __builtin_elementwise_fma(w2, f2{(float)((vw[k] >> 16) & 0xffu), (float)(vw[k] >> 24)}, acc[2 * k + 1]);
      }
    }
    const float rsum = dpp_row_sum_f(wl);
    const float wsum = (__int_as_float(__builtin_amdgcn_readlane(__float_as_int(rsum), 0)) + __int_as_float(__builtin_amdgcn_readlane(__float_as_int(rsum), 16)) +
                        __int_as_float(__builtin_amdgcn_readlane(__float_as_int(rsum), 32)) + __int_as_float(__builtin_amdgcn_readlane(__float_as_int(rsum), 48))) * 0.125f;
#pragma unroll
    for (int k = 0; k < 4; ++k) *reinterpret_cast<float4*>(red + g8 * 128 + (lane & 7) * 16 + 4 * k) = make_float4(acc[2 * k][0], acc[2 * k][1], acc[2 * k + 1][0], acc[2 * k + 1][1]);
    float2 s = make_float2(0.f, 0.f);
#pragma unroll
    for (int g = 0; g < 8; ++g) { const float2 a = *reinterpret_cast<const float2*>(red + g * 128 + 2 * lane); s.x += a.x; s.y += a.y; }
    h2 zo; zo[0] = (_Float16)(s.x - 128.f * wsum); zo[1] = (_Float16)(s.y - 128.f * wsum);
    *reinterpret_cast<h2*>(Zp + (long)t * 1024 + j * 128 + 2 * lane) = zo;
  };
  auto clampt = [&](int t) { return t < NTOK ? t : wslot; };
  uint4 vA[16], vB[16]; float wA[16], wB[16];
  load_list(wslot); gather(vA, wA);
  load_list(clampt(wslot + nw));
  for (int t = wslot; t < NTOK; t += 2 * nw) {
    gather(vB, wB);
    load_list(clampt(t + 2 * nw));
    reduce_store(vA, wA, t);
    gather(vA, wA);
    load_list(clampt(t + 3 * nw));
    if (t + nw < NTOK) reduce_store(vB, wB, t + nw);
  }
}

DI void phase11c(const Params& P) {
  char* ws = P.ws;
  const _Float16* h1h = (const _Float16*)(ws + OFF_H1H); const _Float16* Zp = (const _Float16*)(ws + OFF_ZP);
  const int wid = VT >> 6, lane = VT & 63;
  float4 gg[4], bb[4];
#pragma unroll
  for (int k = 0; k < 4; ++k) { gg[k] = *reinterpret_cast<const float4*>(P.ln2g + lane * 16 + k * 4); bb[k] = *reinterpret_cast<const float4*>(P.ln2b + lane * 16 + k * 4); }
  const int t0 = VB * 4 + wid, tstep = NVB * 4;
  h8 nx0, nx1, na0, na1;
  {
    const int tt = t0 < NTOK ? t0 : 0;
    nx0 = *reinterpret_cast<const h8*>(h1h + (long)tt * 1024 + lane * 16); nx1 = *reinterpret_cast<const h8*>(h1h + (long)tt * 1024 + lane * 16 + 8);
    na0 = *reinterpret_cast<const h8*>(Zp + (long)tt * 1024 + lane * 16); na1 = *reinterpret_cast<const h8*>(Zp + (long)tt * 1024 + lane * 16 + 8);
  }
  for (int t = t0; t < NTOK; t += tstep) {
    const h8 x0 = nx0, x1 = nx1, a0 = na0, a1 = na1;
    {
      const int tn = t + tstep < NTOK ? t + tstep : t;
      nx0 = *reinterpret_cast<const h8*>(h1h + (long)tn * 1024 + lane * 16); nx1 = *reinterpret_cast<const h8*>(h1h + (long)tn * 1024 + lane * 16 + 8);
      na0 = *reinterpret_cast<const h8*>(Zp + (long)tn * 1024 + lane * 16); na1 = *reinterpret_cast<const h8*>(Zp + (long)tn * 1024 + lane * 16 + 8);
    }
    float z[16]; float s = 0.f;
#pragma unroll
    for (int k = 0; k < 8; ++k) { z[k] = (float)a0[k] + ALPHA * (float)x0[k]; z[8 + k] = (float)a1[k] + ALPHA * (float)x1[k]; }
#pragma unroll
    for (int k = 0; k < 16; ++k) s += z[k];
    const float mu = wave_sum(s) * (1.f / 1024.f);
    float q = 0.f;
#pragma unroll
    for (int k = 0; k < 16; ++k) { const float d = z[k] - mu; q += d * d; }
    const float rstd = rsqrtf(wave_sum(q) * (1.f / 1024.f) + 1e-5f);
#pragma unroll
    for (int k = 0; k < 4; ++k) {
      float4 o;
      o.x = (z[4 * k] - mu) * rstd * gg[k].x + bb[k].x; o.y = (z[4 * k + 1] - mu) * rstd * gg[k].y + bb[k].y;
      o.z = (z[4 * k + 2] - mu) * rstd * gg[k].z + bb[k].z; o.w = (z[4 * k + 3] - mu) * rstd * gg[k].w + bb[k].w;
      *reinterpret_cast<float4*>(P.out + (long)t * 1024 + lane * 16 + k * 4) = o;
    }
  }
}

#define XB_TMO      128
#define XB_XCNT(j)  (256  + 64 * (j))
#define XB_XSUB(j)  (1280 + 64 * (j))
#define XB_XGEN(j)  (2304 + 64 * (j))
#define XB_TOP      3328
#define XB_TOPGEN   3392
#define XCD_BAR_WORDS 3456
#define XB_SPIN_CAP (1u << 18)
#define LAS __attribute__((address_space(3)))

DI unsigned xb_ld(unsigned* p)              { return __hip_atomic_load(p, __ATOMIC_RELAXED, __HIP_MEMORY_SCOPE_AGENT); }
DI unsigned xb_add(unsigned* p, unsigned v) { return __hip_atomic_fetch_add(p, v, __ATOMIC_RELAXED, __HIP_MEMORY_SCOPE_AGENT); }
DI unsigned xb_xcc_id() { return (unsigned)__builtin_amdgcn_s_getreg((3 << 11) | 20) & 0xFu; }
#define XB_SPIN(cond, bar) do { unsigned _sp = 0; while (cond) { __builtin_amdgcn_s_sleep(1); \
    if ((++_sp & 255u) == 0u) { if (xb_ld(&(bar)[XB_TMO])) break; if (_sp > XB_SPIN_CAP) { atomicAdd(&(bar)[XB_TMO], 1u); break; } } } } while (0)

struct XcdBarrier {
    unsigned* bar; unsigned x;
    volatile LAS unsigned* st;
};

DI XcdBarrier xcd_barrier_post(unsigned* bar, volatile LAS unsigned* st) {
    XcdBarrier b; b.bar = bar; b.x = xb_xcc_id(); b.st = st;
    if (threadIdx.x == 0) (void)xb_add(&bar[XB_XCNT(b.x)], 1u);
    return b;
}
DI void xcd_barrier_complete(unsigned* bar, unsigned x, unsigned& nloc, unsigned& nx) {
    const unsigned G = gridDim.x * gridDim.y * gridDim.z;
    unsigned sum, cnt, mine, sp = 0u;
    for (;;) {
        sum = 0u; cnt = 0u; mine = 0u;
#pragma unroll
        for (unsigned j = 0; j < 16; ++j) { const unsigned c = xb_ld(&bar[XB_XCNT(j)]); sum += c; cnt += (c > 0u) ? 1u : 0u; mine = (j == x) ? c : mine; }
        if (sum == G) break;
        __builtin_amdgcn_s_sleep(1);
        if ((++sp & 255u) == 0u) { if (xb_ld(&bar[XB_TMO])) break; if (sp > XB_SPIN_CAP) { atomicAdd(&bar[XB_TMO], 1u); break; } }
    }
    nloc = mine > 0u ? mine : 1u; nx = cnt > 0u ? cnt : 1u;
}

DI void xcd_barrier(const XcdBarrier& b) {
    asm volatile("s_waitcnt vmcnt(0)" ::: "memory");
    __syncthreads();
    if (threadIdx.x == 0) {
        unsigned* bar = b.bar;
        __builtin_amdgcn_s_waitcnt(0);
        unsigned nloc = b.st[0], nx = b.st[1];
        if (nloc == 0u) { xcd_barrier_complete(bar, b.x, nloc, nx); b.st[0] = nloc; b.st[1] = nx; }
        const unsigned old = xb_add(&bar[XB_XSUB(b.x)], 1u);
        const unsigned gen = old / nloc;
        if (old + 1u == (gen + 1u) * nloc) {
            __builtin_amdgcn_fence(__ATOMIC_RELEASE, "agent");
            asm volatile("s_waitcnt vmcnt(0)" ::: "memory");
            const unsigned og = xb_add(&bar[XB_TOP], 1u);
            const unsigned tg = og / nx;
            if (og + 1u == (tg + 1u) * nx) xb_add(&bar[XB_TOPGEN], 1u);
            else XB_SPIN(xb_ld(&bar[XB_TOPGEN]) == tg, bar);
            __builtin_amdgcn_fence(__ATOMIC_ACQUIRE, "agent");
            xb_add(&bar[XB_XGEN(b.x)], 1u);
            asm volatile("s_waitcnt vmcnt(0)" ::: "memory");
        } else {
            XB_SPIN(xb_ld(&bar[XB_XGEN(b.x)]) == gen, bar);
            __builtin_amdgcn_fence(__ATOMIC_ACQUIRE, "agent");
            asm volatile("s_waitcnt vmcnt(0)" ::: "memory");
        }
    }
    __syncthreads();
}


__global__ void __launch_bounds__(512, 1) k_mega(Params P) {
  extern __shared__ __attribute__((aligned(16))) char smem_all[];
  char* smem = smem_all + VHALF * VLDS;
  cg::grid_group grid = cg::this_grid();
  volatile LAS unsigned* xb_st = (volatile LAS unsigned*)(smem_all + 2 * VLDS);
  if (RTID == 0) { xb_st[0] = 0u; xb_st[1] = 0u; xb_st[2] = 0u; xb_st[3] = 0u; }
  __syncthreads();
  const XcdBarrier xb = xcd_barrier_post((unsigned*)(P.ws + OFF_BAR), xb_st);
  if (P.out == nullptr) grid.sync();
  phase0(P, smem); xcd_barrier(xb);
  if (PROBE_DUP == 0) { grid.sync(); phase0(P, smem); grid.sync(); }
  phase1(P, smem_all); xcd_barrier(xb);
  if (PROBE_DUP == 1) { grid.sync(); phase1(P, smem_all); grid.sync(); }
  phase2(P, smem); xcd_barrier(xb);
  if (PROBE_DUP == 2) { grid.sync(); phase2(P, smem); grid.sync(); }
  phase3(P, smem); xcd_barrier(xb);
  if (PROBE_DUP == 3) { grid.sync(); phase3(P, smem); grid.sync(); }
  phase4(P, smem); xcd_barrier(xb);
  if (PROBE_DUP == 4) { grid.sync(); phase4(P, smem); grid.sync(); }
  phase5(P, smem); xcd_barrier(xb);
  if (PROBE_DUP == 5) { grid.sync(); phase5(P, smem); grid.sync(); }
  phase6(P, smem_all); xcd_barrier(xb);
  if (PROBE_DUP == 6) { grid.sync(); phase6(P, smem_all); grid.sync(); }
  phase7(P, smem); xcd_barrier(xb);
  if (PROBE_DUP == 7) { grid.sync(); phase7(P, smem); grid.sync(); }
  phase8(P, smem_all); xcd_barrier(xb);
  if (PROBE_DUP == 8) { grid.sync(); phase8(P, smem_all); grid.sync(); }
  phase9(P, smem); xcd_barrier(xb);
  if (PROBE_DUP == 9) { grid.sync(); phase9(P, smem); grid.sync(); }
  phase10(P, smem); xcd_barrier(xb);
  if (PROBE_DUP == 10) { grid.sync(); phase10(P, smem); grid.sync(); }
  phase11a(P, smem_all); xcd_barrier(xb);
  if (PROBE_DUP == 111) { phase11a(P, smem_all); grid.sync(); }
  phase11b(P, smem_all); xcd_barrier(xb);
  if (PROBE_DUP == 112) { phase11b(P, smem_all); grid.sync(); }
  phase11c(P);
  if (PROBE_DUP == 113) { grid.sync(); phase11c(P); }
}

extern "C" void kernel_launch(void* const* d_in, const int* in_sizes, int n_in, void* d_out, int out_size, void* d_ws, size_t ws_size, hipStream_t stream) {
  if (ws_size < WS_NEED) { fprintf(stderr, "workspace too small: %zu\n", ws_size); return; }
  Params P{};
  P.x = (const float*)d_in[0]; P.w_in = (const float*)d_in[1]; P.a_re = (const float*)d_in[2]; P.a_im = (const float*)d_in[3];
  P.log_dt = (const float*)d_in[4]; P.b_re = (const float*)d_in[5]; P.b_im = (const float*)d_in[6]; P.c_re = (const float*)d_in[7];
  P.c_im = (const float*)d_in[8]; P.dsk = (const float*)d_in[9]; P.w_glu = (const float*)d_in[10]; P.w_out = (const float*)d_in[11];
  P.ln1g = (const float*)d_in[12]; P.ln1b = (const float*)d_in[13]; P.w_q = (const float*)d_in[14]; P.subk = (const float*)d_in[15];
  P.pu = (const float*)d_in[16]; P.pv = (const float*)d_in[17]; P.ln2g = (const float*)d_in[18]; P.ln2b = (const float*)d_in[19];
  P.out = (float*)d_out; P.ws = (char*)d_ws;
  static int grid_blocks = 0;
  if (!grid_blocks) {
    int dev = 0, cus = 0, per_cu = 0;
    hipGetDevice(&dev);
    hipDeviceGetAttribute(&cus, hipDeviceAttributeMultiprocessorCount, dev);
    hipFuncSetAttribute((const void*)k_mega, hipFuncAttributeMaxDynamicSharedMemorySize, LDS_BYTES);
    hipOccupancyMaxActiveBlocksPerMultiprocessor(&per_cu, k_mega, 512, LDS_BYTES);
    if (per_cu > 1) per_cu = 1;
    grid_blocks = (cus * per_cu) & ~7;
  }
  hipMemsetAsync((char*)d_ws + OFF_BAR, 0, XCD_BAR_WORDS * sizeof(unsigned), stream);
  void* args[] = {&P};
  hipError_t e = hipLaunchCooperativeKernel((void*)k_mega, dim3(grid_blocks), dim3(512), args, LDS_BYTES, stream);
  if (e != hipSuccess) fprintf(stderr, "cooperative launch failed: %s (grid %d)\n", hipGetErrorString(e), grid_blocks);
}
```

```cpp
#include <hip/hip_runtime.h>
#include <hip/hip_cooperative_groups.h>
#include <cstdio>
#include <cstdint>
namespace cg = cooperative_groups;

#ifndef PROBE_DUP
#define PROBE_DUP -1
#endif
#define DI __device__ __forceinline__
#define RBLK ((int)blockIdx.x)
#define RGRID ((int)gridDim.x)
#define RTID ((int)threadIdx.x)
#define VHALF (RTID >> 8)
#define VT (RTID & 255)
#define VB (RBLK * 2 + VHALF)
#define NVB (RGRID * 2)
constexpr int VLDS = 70912;

typedef unsigned short u16;
using bf16x8 = __attribute__((ext_vector_type(8))) short;
using f32x4  = __attribute__((ext_vector_type(4))) float;
using f32x16 = __attribute__((ext_vector_type(16))) float;
typedef _Float16 h2 __attribute__((ext_vector_type(2)));
typedef _Float16 h8 __attribute__((ext_vector_type(8)));

constexpr int NTOK = 32768, DM = 1024, SEQ = 8192;
constexpr float ALPHA = 1.189207115002721f;
constexpr size_t MB = 1u << 20;
constexpr size_t OFF_QB = 0, OFF_KB = 32 * MB, OFF_UH = 0, OFF_VH = 32 * MB;
constexpr size_t OFF_UQ = 0, OFF_VQ = 16 * MB, OFF_US = 32 * MB, OFF_VS = 33 * MB;
constexpr size_t OFF_XQ = 400 * MB, OFF_SX = 432 * MB, OFF_W2 = 434 * MB, OFF_E2 = 450 * MB, OFF_ZP = 160 * MB;
constexpr size_t OFF_XB = 64 * MB, OFF_YB = 64 * MB, OFF_H1H = 64 * MB;
constexpr size_t OFF_OPART = 128 * MB, OFF_LSE = 256 * MB, OFF_Z1 = 128 * MB, OFF_QP = 128 * MB, OFF_EIDX = 128 * MB, OFF_G = 144 * MB;
constexpr size_t OFF_WY = 260 * MB, OFF_WST = 332 * MB, OFF_SLOC = 340 * MB, OFF_LIST = 348 * MB;
constexpr size_t OFF_H1B = 256 * MB, OFF_ST = 256 * MB;
constexpr size_t OFF_WINT = 384 * MB, OFF_WQT = 388 * MB, OFF_WOT = 392 * MB, OFF_WGT = 394 * MB, OFF_SKB = 394 * MB + 512 * 1024;
constexpr size_t OFF_KTAB = 395 * MB, OFF_KMEAN = 397 * MB, OFF_GCOUNT = 397 * MB + 256 * 1024;
constexpr size_t OFF_VT = 400 * MB, OFF_CAT = 400 * MB, OFF_UG = 464 * MB;
constexpr size_t WS_NEED = 500 * MB;
constexpr size_t OFF_BAR = 398 * MB;
constexpr int UGLD = 1152;
constexpr int LDS_BYTES = 2 * 70912 + 16;

struct Params {
  const float *x, *w_in, *a_re, *a_im, *log_dt, *b_re, *b_im, *c_re, *c_im, *dsk, *w_glu, *w_out, *ln1g, *ln1b, *w_q, *subk, *pu, *pv, *ln2g, *ln2b;
  float* out;
  char* ws;
};

typedef __bf16 bf2_t __attribute__((ext_vector_type(2)));
typedef float f2_t __attribute__((ext_vector_type(2)));
DI unsigned pack2bf(float a, float b) { const f2_t v = {a, b}; return __builtin_bit_cast(unsigned, __builtin_convertvector(v, bf2_t)); }
DI u16 f2bf(float x) { return (u16)(pack2bf(x, 0.f) & 0xffffu); }
DI float bf2f(u16 b) { return __uint_as_float(((unsigned)b) << 16); }
DI float gelu_t(float x) { float u = 0.7978845608028654f * (x + 0.044715f * x * x * x); float e = __expf(2.f * u); float t = 1.f - 2.f / (1.f + e); return 0.5f * x * (1.f + t); }
DI float2 cmul(float2 a, float2 b) { return make_float2(a.x * b.x - a.y * b.y, a.x * b.y + a.y * b.x); }
DI float2 cexpf2(float re, float im) { float e = expf(re); float s, c; sincosf(im, &s, &c); return make_float2(e * c, e * s); }
DI float dpp_row_sum_f0(float v) {
  v += __int_as_float(__builtin_amdgcn_update_dpp(0, __float_as_int(v), 0xB1, 0xF, 0xF, true));
  v += __int_as_float(__builtin_amdgcn_update_dpp(0, __float_as_int(v), 0x4E, 0xF, 0xF, true));
  v += __int_as_float(__builtin_amdgcn_update_dpp(0, __float_as_int(v), 0x141, 0xF, 0xF, true));
  v += __int_as_float(__builtin_amdgcn_update_dpp(0, __float_as_int(v), 0x140, 0xF, 0xF, true));
  return v;
}
DI float rl_f(float v, int l) { return __int_as_float(__builtin_amdgcn_readlane(__float_as_int(v), l)); }
DI float wave_sum(float v) { v = dpp_row_sum_f0(v); return (rl_f(v, 0) + rl_f(v, 16)) + (rl_f(v, 32) + rl_f(v, 48)); }
DI float wave_max(float v) {
  v = fmaxf(v, __int_as_float(__builtin_amdgcn_update_dpp(0, __float_as_int(v), 0xB1, 0xF, 0xF, true)));
  v = fmaxf(v, __int_as_float(__builtin_amdgcn_update_dpp(0, __float_as_int(v), 0x4E, 0xF, 0xF, true)));
  v = fmaxf(v, __int_as_float(__builtin_amdgcn_update_dpp(0, __float_as_int(v), 0x141, 0xF, 0xF, true)));
  v = fmaxf(v, __int_as_float(__builtin_amdgcn_update_dpp(0, __float_as_int(v), 0x140, 0xF, 0xF, true)));
  return fmaxf(fmaxf(rl_f(v, 0), rl_f(v, 16)), fmaxf(rl_f(v, 32), rl_f(v, 48)));
}

template <bool SWAP, class Epi>
DI void gemm_tile(const u16* __restrict__ Ag, long lda, const u16* __restrict__ Bg, long ldb, int ka0, int ka1, int kb0, int kb1, char* shm, Epi&& epi) {
  const int tid = VT, wid = tid >> 6, lane = tid & 63, wr = wid >> 1, wc = wid & 1, fr = lane & 15, fq = lane >> 4;
  const int na = ka1 - ka0, nk = na + (kb1 - kb0);
  f32x4 acc[4][4];
#pragma unroll
  for (int m = 0; m < 4; ++m)
#pragma unroll
    for (int n = 0; n < 4; ++n) acc[m][n] = f32x4{0.f, 0.f, 0.f, 0.f};
  auto stage = [&](int buf, int kt) {
    char* SA = shm + buf * 32768; char* SB = SA + 16384;
#pragma unroll
    for (int i = 0; i < 4; ++i) {
      const int q = i * 256 + tid, r = q >> 3, c16 = (q & 7) ^ ((r >> 1) & 7);
      __builtin_amdgcn_global_load_lds((const unsigned*)(Ag + (long)r * lda + kt * 64 + c16 * 8), (__attribute__((address_space(3))) unsigned*)(SA + q * 16), 16, 0, 0);
      __builtin_amdgcn_global_load_lds((const unsigned*)(Bg + (long)r * ldb + kt * 64 + c16 * 8), (__attribute__((address_space(3))) unsigned*)(SB + q * 16), 16, 0, 0);
    }
  };
  stage(0, ka0 < ka1 ? ka0 : kb0);
  for (int i = 0; i < nk; ++i) {
    asm volatile("s_waitcnt vmcnt(0)" ::: "memory");
    __syncthreads();
    if (i + 1 < nk) { const int j = i + 1; stage(j & 1, j < na ? ka0 + j : kb0 + (j - na)); }
    const char* SA = shm + (i & 1) * 32768; const char* SB = SA + 16384;
#pragma unroll
    for (int ks = 0; ks < 2; ++ks) {
      bf16x8 At[4], Bt[4];
#pragma unroll
      for (int m = 0; m < 4; ++m) {
        const int ra = wr * 64 + m * 16 + fr, rb = wc * 64 + m * 16 + fr;
        At[m] = *reinterpret_cast<const bf16x8*>(SA + ra * 128 + (((ks * 4 + fq) ^ ((ra >> 1) & 7)) * 16));
        Bt[m] = *reinterpret_cast<const bf16x8*>(SB + rb * 128 + (((ks * 4 + fq) ^ ((rb >> 1) & 7)) * 16));
      }
#pragma unroll
      for (int m = 0; m < 4; ++m)
#pragma unroll
        for (int n = 0; n < 4; ++n) acc[m][n] = SWAP ? __builtin_amdgcn_mfma_f32_16x16x32_bf16(Bt[n], At[m], acc[m][n], 0, 0, 0) : __builtin_amdgcn_mfma_f32_16x16x32_bf16(At[m], Bt[n], acc[m][n], 0, 0, 0);
    }
  }
  __syncthreads();
#pragma unroll
  for (int m = 0; m < 4; ++m)
#pragma unroll
    for (int n = 0; n < 4; ++n) { if (SWAP) epi(wr * 64 + m * 16 + fr, wc * 64 + n * 16 + fq * 4, acc[m][n]); else epi(wr * 64 + m * 16 + fq * 4, wc * 64 + n * 16 + fr, acc[m][n]); }
}

template <class Epi>
DI void gemm_tile256(const u16* __restrict__ Ag, long lda, const u16* __restrict__ Bg, long ldb, int nk, char* shm, Epi&& epi) {
  const int tid = RTID, wid = tid >> 6, lane = tid & 63, wr = wid >> 2, wc = wid & 3, fr = lane & 15, fq = lane >> 4;
  f32x4 acc[8][4];
#pragma unroll
  for (int m = 0; m < 8; ++m)
#pragma unroll
    for (int n = 0; n < 4; ++n) acc[m][n] = f32x4{0.f, 0.f, 0.f, 0.f};
  const int q0 = tid, q1 = 512 + tid;
  const int r0 = q0 >> 2, r1 = q1 >> 2, c0 = (q0 & 3) ^ ((r0 >> 2) & 3), c1 = (q1 & 3) ^ ((r1 >> 2) & 3);
  const u16* a0 = Ag + (long)r0 * lda + c0 * 8; const u16* a1 = Ag + (long)r1 * lda + c1 * 8;
  const u16* b0 = Bg + (long)r0 * ldb + c0 * 8; const u16* b1 = Bg + (long)r1 * ldb + c1 * 8;
  auto stage = [&](int j) {
    char* SA = shm + (j & 3) * 32768; char* SB = SA + 16384;
    __builtin_amdgcn_global_load_lds((const unsigned*)(a0 + j * 32), (__attribute__((address_space(3))) unsigned*)(SA + q0 * 16), 16, 0, 0);
    __builtin_amdgcn_global_load_lds((const unsigned*)(a1 + j * 32), (__attribute__((address_space(3))) unsigned*)(SA + q1 * 16), 16, 0, 0);
    __builtin_amdgcn_global_load_lds((const unsigned*)(b0 + j * 32), (__attribute__((address_space(3))) unsigned*)(SB + q0 * 16), 16, 0, 0);
    __builtin_amdgcn_global_load_lds((const unsigned*)(b1 + j * 32), (__attribute__((address_space(3))) unsigned*)(SB + q1 * 16), 16, 0, 0);
  };
  __syncthreads();
  stage(0);
  if (nk > 1) stage(1);
  if (nk > 2) stage(2);
  for (int i = 0; i < nk; ++i) {
    if (i + 2 < nk) asm volatile("s_waitcnt vmcnt(8)" ::: "memory");
    else if (i + 1 < nk) asm volatile("s_waitcnt vmcnt(4)" ::: "memory");
    else asm volatile("s_waitcnt vmcnt(0)" ::: "memory");
    __builtin_amdgcn_s_barrier();
    __builtin_amdgcn_sched_barrier(0);
    const char* SA = shm + (i & 3) * 32768; const char* SB = SA + 16384;
    bf16x8 At[8], Bt[4];
#pragma unroll
    for (int n = 0; n < 4; ++n) { const int rb = wc * 64 + n * 16 + fr; Bt[n] = *reinterpret_cast<const bf16x8*>(SB + rb * 64 + ((fq ^ ((rb >> 2) & 3)) * 16)); }
#pragma unroll
    for (int m = 0; m < 8; ++m) { const int ra = wr * 128 + m * 16 + fr; At[m] = *reinterpret_cast<const bf16x8*>(SA + ra * 64 + ((fq ^ ((ra >> 2) & 3)) * 16)); }
    if (i + 3 < nk) stage(i + 3);
#pragma unroll
    for (int m = 0; m < 8; ++m)
#pragma unroll
      for (int n = 0; n < 4; ++n) acc[m][n] = __builtin_amdgcn_mfma_f32_16x16x32_bf16(Bt[n], At[m], acc[m][n], 0, 0, 0);
  }
  __syncthreads();
#pragma unroll
  for (int m = 0; m < 8; ++m)
#pragma unroll
    for (int n = 0; n < 4; ++n) epi(wr * 128 + m * 16 + fr, wc * 64 + n * 16 + fq * 4, acc[m][n]);
}

DI int xcd_tile(int q, int x, int C) { if (C >= 8) { const int cpx = C >> 3; return (q / cpx) * C + x * cpx + q % cpx; } const int rpx = 8 / C; return (q * rpx + x / C) * C + (x % C); }
#define TILE_LOOP(tile, N, C)                                                                                          \
  for (int q0_ = (RBLK >> 3) * 2, tile = 0;                                                                            \
       q0_ < (N) / 8 && ((tile = xcd_tile((q0_ + VHALF < (N) / 8 ? q0_ + VHALF : q0_), RBLK & 7, (C))), true);          \
       q0_ += (RGRID >> 3) * 2)

DI void transpose_bf16(const float* __restrict__ src, int K, int N, u16* __restrict__ dst) {
  const long total = (long)(K / 8) * N;
  for (long idx = (long)VB * 256 + VT; idx < total; idx += (long)NVB * 256) {
    int n = (int)(idx % N), k8 = (int)(idx / N);
    unsigned w[4];
#pragma unroll
    for (int j = 0; j < 4; ++j) w[j] = pack2bf(src[(long)(k8 * 8 + 2 * j) * N + n], src[(long)(k8 * 8 + 2 * j + 1) * N + n]);
    *reinterpret_cast<uint4*>(dst + (long)n * K + k8 * 8) = make_uint4(w[0], w[1], w[2], w[3]);
  }
}
DI void cvt_bf16(const float* __restrict__ src, long n, u16* __restrict__ dst) {
  for (long idx = (long)VB * 256 + VT; idx < n / 8; idx += (long)NVB * 256) {
    float4 a = reinterpret_cast<const float4*>(src)[idx * 2], b = reinterpret_cast<const float4*>(src)[idx * 2 + 1];
    reinterpret_cast<uint4*>(dst)[idx] = make_uint4(pack2bf(a.x, a.y), pack2bf(a.z, a.w), pack2bf(b.x, b.y), pack2bf(b.z, b.w));
  }
}
DI void cvt_f16(const float* __restrict__ src, long n, _Float16* __restrict__ dst) {
  for (long idx = (long)VB * 256 + VT; idx < n / 8; idx += (long)NVB * 256) {
    float4 a = reinterpret_cast<const float4*>(src)[idx * 2], b = reinterpret_cast<const float4*>(src)[idx * 2 + 1];
    h8 o; o[0] = (_Float16)a.x; o[1] = (_Float16)a.y; o[2] = (_Float16)a.z; o[3] = (_Float16)a.w; o[4] = (_Float16)b.x; o[5] = (_Float16)b.y; o[6] = (_Float16)b.z; o[7] = (_Float16)b.w;
    reinterpret_cast<h8*>(dst)[idx] = o;
  }
}
DI float2 ssm_f(const Params& P, int g, int p, float dt) {
  float ar = P.a_re[g * 64 + p], ai = P.a_im[g * 64 + p];
  float2 lb = cexpf2(ar * dt, ai * dt);
  float nr = lb.x - 1.f, ni = lb.y, den = ar * ar + ai * ai;
  return make_float2((nr * ar + ni * ai) / den, (ni * ar - nr * ai) / den);
}

DI void phase0(const Params& P, char* smem) {
  char* ws = P.ws;
  cvt_bf16(P.x, (long)NTOK * DM, (u16*)(ws + OFF_XB));
  transpose_bf16(P.w_in, 1024, 2048, (u16*)(ws + OFF_WINT));
  transpose_bf16(P.w_glu, 512, 512, (u16*)(ws + OFF_WGT));
  transpose_bf16(P.w_out, 1024, 1024, (u16*)(ws + OFF_WOT));
  transpose_bf16(P.w_q, 1024, 2048, (u16*)(ws + OFF_WQT));
  cvt_bf16(P.subk, 8 * 2 * 128 * 128, (u16*)(ws + OFF_SKB));
  const long gtid = (long)VB * 256 + VT, gstride = (long)NVB * 256;
  {
    u16* Wst = (u16*)(ws + OFF_WST);
    for (long idx = gtid; idx < 32L * 64 * 64; idx += gstride) {
      const int g = (int)(idx >> 12), p = (int)(idx >> 6) & 63, j = (int)idx & 63;
      const float dt = expf(P.log_dt[g]);
      const float ar = P.a_re[g * 64 + p], ai = P.a_im[g * 64 + p];
      const float d = (float)(63 - j);
      const float2 E = cmul(cexpf2(ar * dt * d, ai * dt * d), ssm_f(P, g, p, dt));
      unsigned wr_[8], wi_[8];
#pragma unroll
      for (int q = 0; q < 8; ++q) {
        const float2 v0 = cmul(E, make_float2(P.b_re[(g * 64 + p) * 16 + 2 * q], P.b_im[(g * 64 + p) * 16 + 2 * q]));
        const float2 v1 = cmul(E, make_float2(P.b_re[(g * 64 + p) * 16 + 2 * q + 1], P.b_im[(g * 64 + p) * 16 + 2 * q + 1]));
        wr_[q] = pack2bf(v0.x, v1.x); wi_[q] = pack2bf(v0.y, v1.y);
      }
      uint4* dr = reinterpret_cast<uint4*>(Wst + ((long)g * 128 + 2 * p) * 1024 + j * 16);
      uint4* di = reinterpret_cast<uint4*>(Wst + ((long)g * 128 + 2 * p + 1) * 1024 + j * 16);
      dr[0] = make_uint4(wr_[0], wr_[1], wr_[2], wr_[3]); dr[1] = make_uint4(wr_[4], wr_[5], wr_[6], wr_[7]);
      di[0] = make_uint4(wi_[0], wi_[1], wi_[2], wi_[3]); di[1] = make_uint4(wi_[4], wi_[5], wi_[6], wi_[7]);
    }
  }
  {
    u16* Wy = (u16*)(ws + OFF_WY);
    for (long idx = gtid; idx < 32L * 64 * 64; idx += gstride) {
      const int g = (int)(idx >> 12), i = (int)(idx >> 6) & 63, p = (int)idx & 63;
      const float dt = expf(P.log_dt[g]);
      const float ar = P.a_re[g * 64 + p], ai = P.a_im[g * 64 + p];
      const float d = (float)(i + 1);
      const float2 E = cexpf2(ar * dt * d, ai * dt * d);
#pragma unroll
      for (int h = 0; h < 16; ++h) {
        const float2 z = cmul(make_float2(P.c_re[(g * 16 + h) * 64 + p], P.c_im[(g * 16 + h) * 64 + p]), E);
        *reinterpret_cast<unsigned*>(Wy + ((long)g * 1024 + i * 16 + h) * UGLD + 1024 + 2 * p) = pack2bf(z.x, -z.y);
      }
    }
  }
  {
    float* Ktab = (float*)(ws + OFF_KTAB);
    float2* Es = (float2*)smem;
    for (int item0 = RBLK * 2; item0 < 32 * 64; item0 += RGRID * 2) {
      const int item = item0 + VHALF;
      int g = item >> 6, d = item & 63, tid = VT;
      if (tid < 64) {
        float dt = expf(P.log_dt[g]);
        float ar = P.a_re[g * 64 + tid], ai = P.a_im[g * 64 + tid];
        Es[tid] = cmul(cexpf2(ar * dt * (float)d, ai * dt * (float)d), ssm_f(P, g, tid, dt));
      }
      __syncthreads();
      int h = tid >> 4, hp = tid & 15;
      float s = 0.f;
      for (int p = 0; p < 64; ++p) {
        float2 T = cmul(Es[p], make_float2(P.b_re[(g * 64 + p) * 16 + hp], P.b_im[(g * 64 + p) * 16 + hp]));
        s += P.c_re[(g * 16 + h) * 64 + p] * T.x - P.c_im[(g * 16 + h) * 64 + p] * T.y;
      }
      Ktab[((g * 64 + d) * 16 + h) * 16 + hp] = s;
      __syncthreads();
    }
  }
  {
    int* gcount = (int*)(ws + OFF_GCOUNT);
    for (long idx = gtid; idx < 1024; idx += gstride) gcount[idx] = 0;
  }
}

DI void phase1(const Params& P, char* smem) {
  char* ws = P.ws;
  const u16* xb = (const u16*)(ws + OFF_XB);
  const u16* WinT = (const u16*)(ws + OFF_WINT);
  u16* UG = (u16*)(ws + OFF_UG); u16* Qb = (u16*)(ws + OFF_QB); u16* Kb = (u16*)(ws + OFF_KB); u16* Vt = (u16*)(ws + OFF_VT);
  for (int q = RBLK >> 3; q < 128; q += RGRID >> 3) {
    const int brow = q * 256, bcol = (RBLK & 7) * 256;
    gemm_tile256(xb + (long)brow * 1024, 1024, WinT + (long)bcol * 1024, 1024, 32, smem, [&](int row, int col0, f32x4 v) {
      const int r = brow + row, c = bcol + col0;
      const uint2 pk = make_uint2(pack2bf(v[0], v[1]), pack2bf(v[2], v[3]));
      if (bcol < 512) {
        const int g = c >> 4, hp = c & 15, m = r >> 6, j = r & 63;
        *reinterpret_cast<uint2*>(UG + ((long)g * 512 + m) * UGLD + j * 16 + hp) = pk;
      } else if (bcol < 1024) {
        *reinterpret_cast<uint2*>(Qb + (long)r * 512 + (c - 512)) = pk;
      } else if (bcol < 1536) {
        *reinterpret_cast<uint2*>(Kb + (long)r * 512 + (c - 1024)) = pk;
      } else {
        const int hd = c - 1536, b = r >> 13, l = r & 8191;
#pragma unroll
        for (int j = 0; j < 4; ++j) Vt[((long)(b * 512 + hd + j)) * 8192 + l] = f2bf(v[j]);
      }
    });
  }
  {
    const float* Ktab = (const float*)(ws + OFF_KTAB);
    u16* Wy = (u16*)(ws + OFF_WY);
    for (long idx = (long)VB * 256 + VT; idx < 32L * 1024 * 128; idx += (long)NVB * 256) {
      int g = (int)(idx >> 17), n = (int)(idx >> 7) & 1023, k8 = (int)idx & 127, i = n >> 4, h = n & 15, j = k8 >> 1, hp0 = (k8 & 1) * 8;
      if (k8 * 8 >= ((n >> 7) + 1) * 128) continue;
      uint4 o = make_uint4(0, 0, 0, 0);
      if (j <= i) {
        const float4* kp = reinterpret_cast<const float4*>(Ktab + ((g * 64 + (i - j)) * 16 + h) * 16 + hp0);
        float4 a = kp[0], b = kp[1];
        o = make_uint4(pack2bf(a.x, a.y), pack2bf(a.z, a.w), pack2bf(b.x, b.y), pack2bf(b.z, b.w));
      }
      *reinterpret_cast<uint4*>(Wy + ((long)g * 1024 + n) * UGLD + k8 * 8) = o;
    }
  }
}

DI void phase2(const Params& P, char* smem) {
  char* ws = P.ws;
  const u16* UG = (const u16*)(ws + OFF_UG); const u16* Wst = (const u16*)(ws + OFF_WST);
  float* Sloc = (float*)(ws + OFF_SLOC);
  for (int tile0 = RBLK * 2; tile0 < 32 * 4; tile0 += RGRID * 2) {
    const int tile = tile0 + VHALF;
    const int g = tile >> 2, brow = (tile & 3) * 128;
    gemm_tile<true>(UG + ((long)g * 512 + brow) * UGLD, UGLD, Wst + (long)g * 128 * 1024, 1024, 0, 16, 0, 0, smem, [&](int row, int col0, f32x4 v) {
      *reinterpret_cast<float4*>(Sloc + ((long)g * 512 + brow + row) * 128 + col0) = make_float4(v[0], v[1], v[2], v[3]);
    });
  }
  const u16* Kb = (const u16*)(ws + OFF_KB);
  float* kmean = (float*)(ws + OFF_KMEAN);
  float* red = (float*)smem;
  for (int item0 = RBLK * 2; item0 < 1024; item0 += RGRID * 2) {
    const int item = item0 + VHALF;
    const int bh = item >> 5, n = item & 31, b = bh >> 3, h = bh & 7, tid = VT, d = tid & 63, part = tid >> 6;
    float s = 0.f;
    for (int kk = 0; kk < 64; ++kk) s += bf2f(Kb[((long)(b * 8192 + n * 256 + part * 64 + kk)) * 512 + h * 64 + d]);
    red[tid] = s;
    __syncthreads();
    if (tid < 64) kmean[(bh * 32 + n) * 64 + tid] = (red[tid] + red[tid + 64] + red[tid + 128] + red[tid + 192]) * (1.f / 256.f);
    __syncthreads();
  }
}

DI void phase3(const Params& P, char* smem) {
  char* ws = P.ws;
  {
    u16* UG = (u16*)(ws + OFF_UG); const float* Sloc = (const float*)(ws + OFF_SLOC);
    for (int id = VB * 256 + VT; id < 8192; id += NVB * 256) {
      const int p = id & 63, b = (id >> 6) & 3, g = id >> 8;
      const float dt = expf(P.log_dt[g]);
      const float ar = P.a_re[g * 64 + p], ai = P.a_im[g * 64 + p];
      const float2 lamT = cexpf2(ar * dt * 64.f, ai * dt * 64.f);
      float2 s = make_float2(0.f, 0.f);
      for (int c0 = 0; c0 < 128; c0 += 16) {
        const long m0 = (long)g * 512 + b * 128 + c0;
        float2 loc[16];
#pragma unroll
        for (int k = 0; k < 16; ++k) loc[k] = *reinterpret_cast<const float2*>(Sloc + (m0 + k) * 128 + 2 * p);
#pragma unroll
        for (int k = 0; k < 16; ++k) {
          *reinterpret_cast<unsigned*>(UG + (m0 + k) * UGLD + 1024 + 2 * p) = pack2bf(s.x, s.y);
          s = cmul(lamT, s); s.x += loc[k].x; s.y += loc[k].y;
        }
      }
    }
  }
  {
    const u16* Qb = (const u16*)(ws + OFF_QB);
    const float* kmean = (const float*)(ws + OFF_KMEAN);
    int* gcount = (int*)(ws + OFF_GCOUNT);
    u16* list = (u16*)(ws + OFF_LIST);
    float* km = (float*)smem;
    int* cnt = (int*)(smem + 31 * 64 * 4);
    int* base = cnt + 32;
    for (int item0 = RBLK * 2; item0 < 1024; item0 += RGRID * 2) {
      const int item = item0 + VHALF;
      const int bh = item >> 5, own = (item & 512) ? 31 - (item & 31) : (item & 31), b = bh >> 3, h = bh & 7, tid = VT;
      const bool act = own > 0;
      if (act) for (int i = tid; i < own * 64; i += 256) km[i] = kmean[bh * 32 * 64 + i];
      if (tid < 32) cnt[tid] = 0;
      __syncthreads();
      const int l = own * 256 + tid;
      float v0 = -3e38f, v1 = -3e38f, v2 = -3e38f; int n0 = 0, n1 = 0, n2 = 0;
      if (act) {
        const u16* qrow = Qb + ((long)(b * 8192 + l)) * 512 + h * 64;
        float q[64];
#pragma unroll
        for (int c8 = 0; c8 < 8; ++c8) {
          uint4 w = *reinterpret_cast<const uint4*>(qrow + c8 * 8);
          q[c8 * 8 + 0] = __uint_as_float(w.x << 16); q[c8 * 8 + 1] = __uint_as_float(w.x & 0xffff0000u);
          q[c8 * 8 + 2] = __uint_as_float(w.y << 16); q[c8 * 8 + 3] = __uint_as_float(w.y & 0xffff0000u);
          q[c8 * 8 + 4] = __uint_as_float(w.z << 16); q[c8 * 8 + 5] = __uint_as_float(w.z & 0xffff0000u);
          q[c8 * 8 + 6] = __uint_as_float(w.w << 16); q[c8 * 8 + 7] = __uint_as_float(w.w & 0xffff0000u);
        }
        for (int n = 0; n < own; ++n) {
          float sacc = 0.f;
#pragma unroll
          for (int d = 0; d < 64; ++d) sacc += q[d] * km[n * 64 + d];
          if (sacc > v2) {
            if (sacc > v1) { v2 = v1; n2 = n1; if (sacc > v0) { v1 = v0; n1 = n0; v0 = sacc; n0 = n; } else { v1 = sacc; n1 = n; } }
            else { v2 = sacc; n2 = n; }
          }
        }
      }
      const int nsel = own < 3 ? own : 3;
      int p0 = 0, p1 = 0, p2 = 0;
      if (nsel > 0) p0 = atomicAdd(&cnt[n0], 1);
      if (nsel > 1) p1 = atomicAdd(&cnt[n1], 1);
      if (nsel > 2) p2 = atomicAdd(&cnt[n2], 1);
      __syncthreads();
      if (tid < 32) base[tid] = cnt[tid] > 0 ? atomicAdd(&gcount[bh * 32 + tid], cnt[tid]) : 0;
      __syncthreads();
      if (nsel > 0) list[((long)(bh * 32 + n0)) * 8192 + base[n0] + p0] = (u16)((l << 2) | 0);
      if (nsel > 1) list[((long)(bh * 32 + n1)) * 8192 + base[n1] + p1] = (u16)((l << 2) | 1);
      if (nsel > 2) list[((long)(bh * 32 + n2)) * 8192 + base[n2] + p2] = (u16)((l << 2) | 2);
      __syncthreads();
    }
  }
}

DI float xor32_max(float v) { const auto r = __builtin_amdgcn_permlane32_swap(__float_as_uint(v), __float_as_uint(v), false, false); return fmaxf(__uint_as_float(r[0]), __uint_as_float(r[1])); }
DI float xor32_sum(float v) { const auto r = __builtin_amdgcn_permlane32_swap(__float_as_uint(v), __float_as_uint(v), false, false); return __uint_as_float(r[0]) + __uint_as_float(r[1]); }
DI int crow(int i, int hh) { return (i & 3) + 8 * (i >> 2) + 4 * hh; }

DI void attn_task(const Params& P, int bh, int n, int t, int lane, const char* Ks, const char* Vs) {
  char* ws = P.ws;
  const u16* Qb = (const u16*)(ws + OFF_QB);
  const int* gcount = (const int*)(ws + OFF_GCOUNT); const u16* list = (const u16*)(ws + OFF_LIST);
  u16* Opart = (u16*)(ws + OFF_OPART); float* Lse = (float*)(ws + OFF_LSE);
  const int b = bh >> 3, h = bh & 7, r = lane & 31, hh = lane >> 5;
  const bool own = t < 8;
  int lq, slot; bool valid = true;
  if (own) { lq = n * 256 + t * 32 + r; slot = 3; }
  else {
    const int cnt = gcount[bh * 32 + n], idx = (t - 8) * 32 + r;
    valid = idx < cnt;
    const int e = list[((long)(bh * 32 + n)) * 8192 + (valid ? idx : 0)];
    lq = e >> 2; slot = e & 3;
  }
  bf16x8 qf[4];
  {
    const u16* qrow = Qb + ((long)(b * 8192 + lq)) * 512 + h * 64 + 8 * hh;
#pragma unroll
    for (int s = 0; s < 4; ++s) qf[s] = *reinterpret_cast<const bf16x8*>(qrow + 16 * s);
  }
  float m_run = -1e30f, l_run = 0.f;
  f32x16 O0, O1;
#pragma unroll
  for (int i = 0; i < 16; ++i) { O0[i] = 0.f; O1[i] = 0.f; }
  const int nkt = own ? (t + 1) : 8;
  for (int kt = 0; kt < nkt; ++kt) {
    const int kbase = n * 256 + kt * 32;
    const int krow = kt * 32 + r;
    f32x16 S;
#pragma unroll
    for (int i = 0; i < 16; ++i) S[i] = 0.f;
#pragma unroll
    for (int s = 0; s < 4; ++s) {
      const bf16x8 kf = *reinterpret_cast<const bf16x8*>(Ks + krow * 128 + (((2 * s + hh) ^ ((krow >> 1) & 7)) * 16));
      S = __builtin_amdgcn_mfma_f32_32x32x16_bf16(kf, qf[s], S, 0, 0, 0);
    }
    const bool diag = own && (kt == t);
    constexpr float SC2 = 0.125f * 1.4426950408889634f;
    float mx = -1e30f;
#pragma unroll
    for (int i = 0; i < 16; ++i) {
      if (diag && (kbase + crow(i, hh) > lq)) S[i] = -1e30f;
      mx = fmaxf(mx, S[i]);
    }
    mx = xor32_max(mx);
    const float m_new = fmaxf(m_run, mx * SC2);
    const float alpha = __builtin_amdgcn_exp2f(m_run - m_new);
    float rs = 0.f;
#pragma unroll
    for (int i = 0; i < 16; ++i) { float pv = __builtin_amdgcn_exp2f(fmaf(S[i], SC2, -m_new)); S[i] = pv; rs += pv; }
    rs = xor32_sum(rs);
    l_run = l_run * alpha + rs; m_run = m_new;
    if (__ballot(alpha != 1.f)) {
#pragma unroll
      for (int i = 0; i < 16; ++i) { O0[i] *= alpha; O1[i] *= alpha; }
    }
#pragma unroll
    for (int s = 0; s < 2; ++s) {
      const uint4 ppk = make_uint4(pack2bf(S[8 * s], S[8 * s + 1]), pack2bf(S[8 * s + 2], S[8 * s + 3]), pack2bf(S[8 * s + 4], S[8 * s + 5]), pack2bf(S[8 * s + 6], S[8 * s + 7]));
      const bf16x8 pf = __builtin_bit_cast(bf16x8, ppk);
#pragma unroll
      for (int dt = 0; dt < 2; ++dt) {
        const char* vp = Vs + (dt * 32 + r) * 528 + (kt * 32 + 16 * s + 4 * hh) * 2;
        const uint2 lo = *reinterpret_cast<const uint2*>(vp), hi = *reinterpret_cast<const uint2*>(vp + 16);
        const uint4 vv = make_uint4(lo.x, lo.y, hi.x, hi.y);
        if (dt == 0) O0 = __builtin_amdgcn_mfma_f32_32x32x16_bf16(__builtin_bit_cast(bf16x8, vv), pf, O0, 0, 0, 0);
        else O1 = __builtin_amdgcn_mfma_f32_32x32x16_bf16(__builtin_bit_cast(bf16x8, vv), pf, O1, 0, 0, 0);
      }
    }
  }
  if (valid) {
    const float inv = 1.f / l_run;
    const long rowid = ((long)(b * 8192 + lq) * 8 + h) * 4 + slot;
    u16* op = Opart + rowid * 64;
#pragma unroll
    for (int gq = 0; gq < 4; ++gq) {
      *reinterpret_cast<uint2*>(op + 8 * gq + 4 * hh) = make_uint2(pack2bf(O0[4 * gq] * inv, O0[4 * gq + 1] * inv), pack2bf(O0[4 * gq + 2] * inv, O0[4 * gq + 3] * inv));
      *reinterpret_cast<uint2*>(op + 32 + 8 * gq + 4 * hh) = make_uint2(pack2bf(O1[4 * gq] * inv, O1[4 * gq + 1] * inv), pack2bf(O1[4 * gq + 2] * inv, O1[4 * gq + 3] * inv));
    }
    if (hh == 0) Lse[rowid] = (m_run + __log2f(l_run)) * 0.6931471805599453f;
  }
}

DI void phase4(const Params& P, char* smem) {
  char* ws = P.ws;
  const u16* UG = (const u16*)(ws + OFF_UG); const u16* Wy = (const u16*)(ws + OFF_WY);
  u16* Yb = (u16*)(ws + OFF_YB);
  TILE_LOOP(tile, 32 * 4 * 8, 8) {
    const int trow = tile >> 3, g = (trow >> 5) * 8 + (tile & 7), brow = (trow & 3) * 128, cidx = (trow >> 2) & 7, bcol = ((trow & 64) ? 7 - cidx : cidx) * 128;
    gemm_tile<true>(UG + ((long)g * 512 + brow) * UGLD, UGLD, Wy + ((long)g * 1024 + bcol) * UGLD, UGLD, 0, (bcol + 128) / 64, 16, 18, smem, [&](int row, int col0, f32x4 v) {
      const int n = bcol + col0, i = n >> 4, h = n & 15, m = brow + row;
      const float4 dsk = *reinterpret_cast<const float4*>(P.dsk + g * 16 + h);
      const uint2 uu = *reinterpret_cast<const uint2*>(UG + ((long)g * 512 + m) * UGLD + n);
      const float y0 = gelu_t(v[0] + dsk.x * __uint_as_float(uu.x << 16)), y1 = gelu_t(v[1] + dsk.y * __uint_as_float(uu.x & 0xffff0000u));
      const float y2 = gelu_t(v[2] + dsk.z * __uint_as_float(uu.y << 16)), y3 = gelu_t(v[3] + dsk.w * __uint_as_float(uu.y & 0xffff0000u));
      *reinterpret_cast<uint2*>(Yb + ((long)m * 64 + i) * 512 + g * 16 + h) = make_uint2(pack2bf(y0, y1), pack2bf(y2, y3));
    });
  }
  const int wid = VT >> 6, lane = VT & 63, tid = VT;
  const int* gcount = (const int*)(ws + OFF_GCOUNT);
  const u16* Kb = (const u16*)(ws + OFF_KB); const u16* Vt = (const u16*)(ws + OFF_VT);
  char* Ks = smem; char* Vs = smem + 32768;
  int* pre = (int*)(smem + 32768 + 33792);
  int* part = pre + 1032;
  __syncthreads();
  {
    if (tid < 32) { int s = 0; for (int k = 0; k < 32; ++k) s += (4 + ((gcount[tid * 32 + k] + 31) >> 5) + 7) >> 3; part[tid + 1] = s; }
    __syncthreads();
    if (tid == 0) { part[0] = 0; for (int k = 1; k <= 32; ++k) part[k] += part[k - 1]; }
    __syncthreads();
    if (tid < 32) { int s = part[tid]; for (int k = 0; k < 32; ++k) { pre[tid * 32 + k] = s; s += (4 + ((gcount[tid * 32 + k] + 31) >> 5) + 7) >> 3; } }
    if (tid == 0) pre[1024] = part[32];
    __syncthreads();
  }
  const int total = pre[1024];
  const int per = (total + 7) >> 3, slot = (RBLK >> 3) * 2 + VHALF, nslot = (RGRID >> 3) * 2;
  for (int k0 = 0; k0 < per; k0 += nslot) {
    const int kk = k0 + slot, it_ = (RBLK & 7) * per + kk;
    const bool act = kk < per && it_ < total;
    const int it = act ? it_ : 0;
    int lo = 0, hi = 1024;
    while (hi - lo > 1) { const int mid = (lo + hi) >> 1; if (pre[mid] <= it) lo = mid; else hi = mid; }
    const int bh = lo >> 5, n = lo & 31, b = bh >> 3, h = bh & 7;
    const int ntask = 4 + ((gcount[lo] + 31) >> 5);
    const int task = (it - pre[lo]) * 8 + wid;
    uint4 kr[8], vr[8];
#pragma unroll
    for (int i = 0; i < 8; ++i) {
      const int q = i * 256 + tid;
      kr[i] = *reinterpret_cast<const uint4*>(Kb + ((long)(b * 8192 + n * 256 + (q >> 3))) * 512 + h * 64 + (q & 7) * 8);
      vr[i] = *reinterpret_cast<const uint4*>(Vt + ((long)(bh * 64 + (q >> 5))) * 8192 + n * 256 + (q & 31) * 8);
    }
#pragma unroll
    for (int i = 0; i < 8; ++i) {
      const int q = i * 256 + tid, row = q >> 3;
      *reinterpret_cast<uint4*>(Ks + row * 128 + (((q & 7) ^ ((row >> 1) & 7)) * 16)) = kr[i];
      *reinterpret_cast<uint4*>(Vs + (q >> 5) * 528 + (q & 31) * 16) = vr[i];
    }
    __syncthreads();
    if (act && task < ntask) {
      if (task < 4) { attn_task(P, bh, n, task, lane, Ks, Vs); attn_task(P, bh, n, 7 - task, lane, Ks, Vs); }
      else attn_task(P, bh, n, task - 4 + 8, lane, Ks, Vs);
    }
    if (act && task + 4 < ntask) attn_task(P, bh, n, task + 4 - 4 + 8, lane, Ks, Vs);
    __syncthreads();
  }
}

DI void phase5(const Params& P, char* smem) {
  char* ws = P.ws;
  const u16* Yb = (const u16*)(ws + OFF_YB); const u16* WgT = (const u16*)(ws + OFF_WGT);
  u16* cat = (u16*)(ws + OFF_CAT);
  TILE_LOOP(tile, 256 * 4, 4) {
    const int brow = (tile >> 2) * 128, bcol = (tile & 3) * 128;
    gemm_tile<true>(Yb + (long)brow * 512, 512, WgT + (long)bcol * 512, 512, 0, 8, 0, 0, smem, [&](int row, int col0, f32x4 v) {
      const long r = brow + row; const int c = bcol + col0;
      const uint2 yy = *reinterpret_cast<const uint2*>(Yb + r * 512 + c);
      const float o0 = __uint_as_float(yy.x << 16) / (1.f + __expf(-v[0])), o1 = __uint_as_float(yy.x & 0xffff0000u) / (1.f + __expf(-v[1]));
      const float o2 = __uint_as_float(yy.y << 16) / (1.f + __expf(-v[2])), o3 = __uint_as_float(yy.y & 0xffff0000u) / (1.f + __expf(-v[3]));
      *reinterpret_cast<uint2*>(cat + r * 1024 + c) = make_uint2(pack2bf(o0, o1), pack2bf(o2, o3));
    });
  }
  const u16* Opart = (const u16*)(ws + OFF_OPART); const float* Lse = (const float*)(ws + OFF_LSE);
  for (long idx = (long)VB * 256 + VT; idx < (long)NTOK * 64; idx += (long)NVB * 256) {
    const int dg = (int)idx & 7, h = (int)(idx >> 3) & 7; const long tok = idx >> 6;
    const int l = (int)(tok & 8191); const int ownb = l >> 8; const int nv = ownb < 3 ? ownb : 3;
    const long base = (tok * 8 + h) * 4;
    float ls[4]; float mx = -3e38f;
#pragma unroll
    for (int s = 0; s < 4; ++s) { const bool ok = (s == 3) || (s < nv); ls[s] = ok ? Lse[base + s] : -3e38f; mx = fmaxf(mx, ls[s]); }
    float acc[8]; float wsum = 0.f;
#pragma unroll
    for (int k = 0; k < 8; ++k) acc[k] = 0.f;
#pragma unroll
    for (int s = 0; s < 4; ++s) {
      const bool ok = (s == 3) || (s < nv);
      if (ok) {
        const float w = __expf(ls[s] - mx); wsum += w;
        uint4 o = *reinterpret_cast<const uint4*>(Opart + (base + s) * 64 + dg * 8);
        acc[0] += w * __uint_as_float(o.x << 16); acc[1] += w * __uint_as_float(o.x & 0xffff0000u);
        acc[2] += w * __uint_as_float(o.y << 16); acc[3] += w * __uint_as_float(o.y & 0xffff0000u);
        acc[4] += w * __uint_as_float(o.z << 16); acc[5] += w * __uint_as_float(o.z & 0xffff0000u);
        acc[6] += w * __uint_as_float(o.w << 16); acc[7] += w * __uint_as_float(o.w & 0xffff0000u);
      }
    }
    const float inv = 1.f / wsum;
    *reinterpret_cast<uint4*>(cat + tok * 1024 + 512 + h * 64 + dg * 8) =
        make_uint4(pack2bf(acc[0] * inv, acc[1] * inv), pack2bf(acc[2] * inv, acc[3] * inv), pack2bf(acc[4] * inv, acc[5] * inv), pack2bf(acc[6] * inv, acc[7] * inv));
  }
}

DI void phase6(const Params& P, char* smem) {
  char* ws = P.ws;
  const u16* cat = (const u16*)(ws + OFF_CAT); const u16* WoT = (const u16*)(ws + OFF_WOT);
  float* Z1 = (float*)(ws + OFF_Z1);
  for (int q = RBLK >> 3; q < 64; q += RGRID >> 3) {
    const int brow = (q * 2 + ((RBLK & 7) >> 2)) * 256, bcol = (RBLK & 3) * 256;
    gemm_tile256(cat + (long)brow * 1024, 1024, WoT + (long)bcol * 1024, 1024, 32, smem, [&](int row, int col0, f32x4 v) {
      const long o = (long)(brow + row) * 1024 + bcol + col0;
      const float4 xs = *reinterpret_cast<const float4*>(P.x + o);
      *reinterpret_cast<float4*>(Z1 + o) = make_float4(ALPHA * xs.x + v[0], ALPHA * xs.y + v[1], ALPHA * xs.z + v[2], ALPHA * xs.w + v[3]);
    });
  }
}

DI void phase7(const Params& P, char* smem) {
  char* ws = P.ws;
  const float* Z1 = (const float*)(ws + OFF_Z1);
  _Float16* h1h = (_Float16*)(ws + OFF_H1H); u16* h1b = (u16*)(ws + OFF_H1B);
  const int wid = VT >> 6, lane = VT & 63;
  for (int row = VB * 4 + wid; row < NTOK; row += NVB * 4) {
    float4 z[4]; float s = 0.f;
#pragma unroll
    for (int k = 0; k < 4; ++k) { z[k] = *reinterpret_cast<const float4*>(Z1 + (long)row * 1024 + k * 256 + lane * 4); s += z[k].x + z[k].y + z[k].z + z[k].w; }
    const float mu = wave_sum(s) * (1.f / 1024.f);
    float q = 0.f;
#pragma unroll
    for (int k = 0; k < 4; ++k) { float a = z[k].x - mu, b = z[k].y - mu, c = z[k].z - mu, d = z[k].w - mu; q += a * a + b * b + c * c + d * d; }
    const float rstd = rsqrtf(wave_sum(q) * (1.f / 1024.f) + 1e-5f);
#pragma unroll
    for (int k = 0; k < 4; ++k) {
      const int c0 = k * 256 + lane * 4;
      const float4 gg = *reinterpret_cast<const float4*>(P.ln1g + c0), bb = *reinterpret_cast<const float4*>(P.ln1b + c0);
      const float y0 = (z[k].x - mu) * rstd * gg.x + bb.x, y1 = (z[k].y - mu) * rstd * gg.y + bb.y, y2 = (z[k].z - mu) * rstd * gg.z + bb.z, y3 = (z[k].w - mu) * rstd * gg.w + bb.w;
      typedef _Float16 h4 __attribute__((ext_vector_type(4)));
      h4 hv; hv[0] = (_Float16)y0; hv[1] = (_Float16)y1; hv[2] = (_Float16)y2; hv[3] = (_Float16)y3;
      *reinterpret_cast<h4*>(h1h + (long)row * 1024 + c0) = hv;
      *reinterpret_cast<uint2*>(h1b + (long)row * 1024 + c0) = make_uint2(pack2bf(y0, y1), pack2bf(y2, y3));
      z[k] = make_float4(y0, y1, y2, y3);
    }
    float am = 0.f;
#pragma unroll
    for (int k = 0; k < 4; ++k) am = fmaxf(am, fmaxf(fmaxf(fabsf(z[k].x), fabsf(z[k].y)), fmaxf(fabsf(z[k].z), fabsf(z[k].w))));
    am = wave_max(am);
    const float xinv = am > 0.f ? 127.f / am : 0.f;
#pragma unroll
    for (int k = 0; k < 4; ++k) {
      const unsigned pk = ((unsigned)((int)rintf(z[k].x * xinv) & 0xff)) | ((unsigned)((int)rintf(z[k].y * xinv) & 0xff) << 8) |
                          ((unsigned)((int)rintf(z[k].z * xinv) & 0xff) << 16) | ((unsigned)((int)rintf(z[k].w * xinv) & 0xff) << 24);
      *reinterpret_cast<unsigned*>(ws + OFF_XQ + (long)row * 1024 + k * 256 + lane * 4) = pk;
    }
    if (lane == 0) reinterpret_cast<float*>(ws + OFF_SX)[row] = am * (1.f / 127.f);
  }
  for (int row = VB * 4 + wid; row < 2 * 16384; row += NVB * 4) {
    const bool isv = row >= 16384; const int e = row & 16383;
    const float* src = (isv ? P.pv : P.pu) + (long)e * 1024 + lane * 16;
    float f[16];
#pragma unroll
    for (int k = 0; k < 4; ++k) { const float4 a = reinterpret_cast<const float4*>(src)[k]; f[4 * k] = a.x; f[4 * k + 1] = a.y; f[4 * k + 2] = a.z; f[4 * k + 3] = a.w; }
    float am = 0.f;
#pragma unroll
    for (int k = 0; k < 16; ++k) am = fmaxf(am, fabsf(f[k]));
    am = wave_max(am);
    const float inv = am > 0.f ? 127.f / am : 0.f;
    unsigned w[4];
#pragma unroll
    for (int k = 0; k < 4; ++k) {
      unsigned pk = 0;
#pragma unroll
      for (int b = 0; b < 4; ++b) { int q = (int)rintf(f[4 * k + b] * inv); q = q > 127 ? 127 : (q < -127 ? -127 : q); pk |= ((unsigned)((isv ? q + 128 : q) & 0xff)) << (8 * b); }
      w[k] = pk;
    }
    *reinterpret_cast<uint4*>(ws + (isv ? OFF_VQ + ((long)(lane >> 3) * 16384 + e) * 128 + (lane & 7) * 16 : OFF_UQ + (long)e * 1024 + lane * 16)) = make_uint4(w[0], w[1], w[2], w[3]);
    if (lane == 0) reinterpret_cast<float*>(ws + (isv ? OFF_VS : OFF_US))[e] = am * (1.f / 127.f);
  }
}

DI void phase8(const Params& P, char* smem) {
  char* ws = P.ws;
  const u16* h1b = (const u16*)(ws + OFF_H1B); const u16* WqT = (const u16*)(ws + OFF_WQT);
  u16* Qp = (u16*)(ws + OFF_QP);
  for (int q = RBLK >> 3; q < 128; q += RGRID >> 3) {
    const int brow = q * 256, bcol = (RBLK & 7) * 256;
    gemm_tile256(h1b + (long)brow * 1024, 1024, WqT + (long)bcol * 1024, 1024, 32, smem, [&](int row, int col0, f32x4 v) {
      *reinterpret_cast<uint2*>(Qp + (long)(brow + row) * 2048 + bcol + col0) = make_uint2(pack2bf(v[0], v[1]), pack2bf(v[2], v[3]));
    });
  }
}

DI void phase9(const Params& P, char* smem) {
  char* ws = P.ws;
  const u16* Qp = (const u16*)(ws + OFF_QP); const u16* SKb = (const u16*)(ws + OFF_SKB);
  _Float16* ST = (_Float16*)(ws + OFF_ST);
  TILE_LOOP(tile, 256 * 16, 16) {
    const int brow = (tile >> 4) * 128, hc = tile & 15;
    gemm_tile<false>(Qp + (long)brow * 2048 + hc * 128, 2048, SKb + (long)hc * 128 * 128, 128, 0, 2, 0, 0, smem, [&](int row0, int col, f32x4 v) {
      typedef _Float16 h4 __attribute__((ext_vector_type(4)));
      h4 hv; hv[0] = (_Float16)v[0]; hv[1] = (_Float16)v[1]; hv[2] = (_Float16)v[2]; hv[3] = (_Float16)v[3];
      *reinterpret_cast<h4*>(ST + ((long)(hc * 128 + col)) * NTOK + brow + row0) = hv;
    });
  }
}

DI unsigned umax_(unsigned a, unsigned b) { return a > b ? a : b; }
DI unsigned umin_(unsigned a, unsigned b) { return a < b ? a : b; }
#define CE(a, b) { const unsigned hi_ = umax_(a, b), lo_ = umin_(a, b); a = hi_; b = lo_; }
#define SORT16(A) CE(A[0],A[1]) CE(A[2],A[3]) CE(A[4],A[5]) CE(A[6],A[7]) CE(A[8],A[9]) CE(A[10],A[11]) CE(A[12],A[13]) CE(A[14],A[15]) CE(A[0],A[2]) CE(A[1],A[3]) CE(A[4],A[6]) CE(A[5],A[7]) CE(A[8],A[10]) CE(A[9],A[11]) CE(A[12],A[14]) CE(A[13],A[15]) CE(A[1],A[2]) CE(A[5],A[6]) CE(A[9],A[10]) CE(A[13],A[14]) CE(A[0],A[4]) CE(A[1],A[5]) CE(A[2],A[6]) CE(A[3],A[7]) CE(A[8],A[12]) CE(A[9],A[13]) CE(A[10],A[14]) CE(A[11],A[15]) CE(A[2],A[4]) CE(A[3],A[5]) CE(A[10],A[12]) CE(A[11],A[13]) CE(A[1],A[2]) CE(A[3],A[4]) CE(A[5],A[6]) CE(A[9],A[10]) CE(A[11],A[12]) CE(A[13],A[14]) CE(A[0],A[8]) CE(A[1],A[9]) CE(A[2],A[10]) CE(A[3],A[11]) CE(A[4],A[12]) CE(A[5],A[13]) CE(A[6],A[14]) CE(A[7],A[15]) CE(A[4],A[8]) CE(A[5],A[9]) CE(A[6],A[10]) CE(A[7],A[11]) CE(A[2],A[4]) CE(A[3],A[5]) CE(A[6],A[8]) CE(A[7],A[9]) CE(A[10],A[12]) CE(A[11],A[13]) CE(A[1],A[2]) CE(A[3],A[4]) CE(A[5],A[6]) CE(A[7],A[8]) CE(A[9],A[10]) CE(A[11],A[12]) CE(A[13],A[14])
#define MERGE16(R,G) R[0]=umax_(R[0],G[15]); R[1]=umax_(R[1],G[14]); R[2]=umax_(R[2],G[13]); R[3]=umax_(R[3],G[12]); R[4]=umax_(R[4],G[11]); R[5]=umax_(R[5],G[10]); R[6]=umax_(R[6],G[9]); R[7]=umax_(R[7],G[8]); R[8]=umax_(R[8],G[7]); R[9]=umax_(R[9],G[6]); R[10]=umax_(R[10],G[5]); R[11]=umax_(R[11],G[4]); R[12]=umax_(R[12],G[3]); R[13]=umax_(R[13],G[2]); R[14]=umax_(R[14],G[1]); R[15]=umax_(R[15],G[0]); CE(R[0],R[8]) CE(R[1],R[9]) CE(R[2],R[10]) CE(R[3],R[11]) CE(R[4],R[12]) CE(R[5],R[13]) CE(R[6],R[14]) CE(R[7],R[15]) CE(R[0],R[4]) CE(R[1],R[5]) CE(R[2],R[6]) CE(R[3],R[7]) CE(R[8],R[12]) CE(R[9],R[13]) CE(R[10],R[14]) CE(R[11],R[15]) CE(R[0],R[2]) CE(R[1],R[3]) CE(R[4],R[6]) CE(R[5],R[7]) CE(R[8],R[10]) CE(R[9],R[11]) CE(R[12],R[14]) CE(R[13],R[15]) CE(R[0],R[1]) CE(R[2],R[3]) CE(R[4],R[5]) CE(R[6],R[7]) CE(R[8],R[9]) CE(R[10],R[11]) CE(R[12],R[13]) CE(R[14],R[15])

DI void topk_half(const _Float16* __restrict__ sp, unsigned (&R)[16]) {
#pragma unroll
  for (int e = 0; e < 16; ++e) R[e] = 0u;
#pragma unroll 1
  for (int gi = 0; gi < 8; ++gi) {
    unsigned Gk[16];
#pragma unroll
    for (int e = 0; e < 16; ++e) {
      const int n = gi * 16 + e;
      const unsigned bits = __builtin_bit_cast(unsigned short, sp[(long)n * NTOK]);
      const unsigned o = (bits & 0x8000u) ? (~bits & 0xffffu) : (bits | 0x8000u);
      Gk[e] = (o << 16) | (unsigned)(127 - n);
    }
    SORT16(Gk)
    MERGE16(R, Gk)
  }
}
DI float key_val16(unsigned k) { const unsigned o = k >> 16; const unsigned short b = (unsigned short)((o & 0x8000u) ? (o & 0x7fffu) : (~o & 0xffffu)); return (float)__builtin_bit_cast(_Float16, b); }
DI unsigned candkey(float s, int pos) { const unsigned b = __float_as_uint(s); const unsigned o = (b >> 31) ? ~b : (b ^ 0x80000000u); return (o & 0xffffff00u) | (unsigned)(255 - pos); }
DI unsigned lut4(const unsigned (&W)[4], int a) { const int j = a >> 2; const unsigned w = j == 0 ? W[0] : (j == 1 ? W[1] : (j == 2 ? W[2] : W[3])); return (w >> ((a & 3) * 8)) & 0xffu; }

DI void phase10(const Params& P, char* smem) {
  char* ws = P.ws;
  const _Float16* ST = (const _Float16*)(ws + OFF_ST);
  int* Eidx = (int*)(ws + OFF_EIDX); float* G = (float*)(ws + OFF_G);
  for (long id = (long)VB * 256 + VT; id < (long)NTOK * 8; id += (long)NVB * 256) {
    const int t = (int)(id & (NTOK - 1)), h = (int)(id >> 15);
    unsigned R1[16], R2[16];
    topk_half(ST + ((long)(h * 2 + 0) * 128) * NTOK + t, R1);
    topk_half(ST + ((long)(h * 2 + 1) * 128) * NTOK + t, R2);
    float v1[16], v2[16]; unsigned W1[4] = {0u, 0u, 0u, 0u}, W2[4] = {0u, 0u, 0u, 0u};
#pragma unroll
    for (int k = 0; k < 16; ++k) {
      v1[k] = key_val16(R1[k]); v2[k] = key_val16(R2[k]);
      W1[k >> 2] |= (127u - (R1[k] & 127u)) << ((k & 3) * 8);
      W2[k >> 2] |= (127u - (R2[k] & 127u)) << ((k & 3) * 8);
    }
    unsigned C0[16], C1[16], C2[16], C3[16];
    C0[0] = candkey(v1[0] + v2[0], 0);
    C0[1] = candkey(v1[0] + v2[1], 1);
    C0[2] = candkey(v1[0] + v2[2], 2);
    C0[3] = candkey(v1[0] + v2[3], 3);
    C0[4] = candkey(v1[0] + v2[4], 4);
    C0[5] = candkey(v1[0] + v2[5], 5);
    C0[6] = candkey(v1[0] + v2[6], 6);
    C0[7] = candkey(v1[0] + v2[7], 7);
    C0[8] = candkey(v1[0] + v2[8], 8);
    C0[9] = candkey(v1[0] + v2[9], 9);
    C0[10] = candkey(v1[0] + v2[10], 10);
    C0[11] = candkey(v1[0] + v2[11], 11);
    C0[12] = candkey(v1[0] + v2[12], 12);
    C0[13] = candkey(v1[0] + v2[13], 13);
    C0[14] = candkey(v1[0] + v2[14], 14);
    C0[15] = candkey(v1[0] + v2[15], 15);
    C1[0] = candkey(v1[1] + v2[0], 16);
    C1[1] = candkey(v1[1] + v2[1], 17);
    C1[2] = candkey(v1[1] + v2[2], 18);
    C1[3] = candkey(v1[1] + v2[3], 19);
    C1[4] = candkey(v1[1] + v2[4], 20);
    C1[5] = candkey(v1[1] + v2[5], 21);
    C1[6] = candkey(v1[1] + v2[6], 22);
    C1[7] = candkey(v1[1] + v2[7], 23);
    C1[8] = candkey(v1[2] + v2[0], 32);
    C1[9] = candkey(v1[2] + v2[1], 33);
    C1[10] = candkey(v1[2] + v2[2], 34);
    C1[11] = candkey(v1[2] + v2[3], 35);
    C1[12] = candkey(v1[2] + v2[4], 36);
    C1[13] = candkey(v1[3] + v2[0], 48);
    C1[14] = candkey(v1[3] + v2[1], 49);
    C1[15] = candkey(v1[3] + v2[2], 50);
    C2[0] = candkey(v1[3] + v2[3], 51);
    C2[1] = candkey(v1[4] + v2[0], 64);
    C2[2] = candkey(v1[4] + v2[1], 65);
    C2[3] = candkey(v1[4] + v2[2], 66);
    C2[4] = candkey(v1[5] + v2[0], 80);
    C2[5] = candkey(v1[5] + v2[1], 81);
    C2[6] = candkey(v1[6] + v2[0], 96);
    C2[7] = candkey(v1[6] + v2[1], 97);
    C2[8] = candkey(v1[7] + v2[0], 112);
    C2[9] = candkey(v1[7] + v2[1], 113);
    C2[10] = candkey(v1[8] + v2[0], 128);
    C2[11] = candkey(v1[9] + v2[0], 144);
    C2[12] = candkey(v1[10] + v2[0], 160);
    C2[13] = candkey(v1[11] + v2[0], 176);
    C2[14] = candkey(v1[12] + v2[0], 192);
    C2[15] = candkey(v1[13] + v2[0], 208);
    C3[0] = candkey(v1[14] + v2[0], 224);
    C3[1] = candkey(v1[15] + v2[0], 240);
    C3[2] = 0u;
    C3[3] = 0u;
    C3[4] = 0u;
    C3[5] = 0u;
    C3[6] = 0u;
    C3[7] = 0u;
    C3[8] = 0u;
    C3[9] = 0u;
    C3[10] = 0u;
    C3[11] = 0u;
    C3[12] = 0u;
    C3[13] = 0u;
    C3[14] = 0u;
    C3[15] = 0u;
    SORT16(C1) SORT16(C2) SORT16(C3)
    MERGE16(C0, C1) MERGE16(C0, C2) MERGE16(C0, C3)
    float e[16]; int te[16]; float sum = 0.f;
    const float tv0 = [&]() { const unsigned o = C0[0] & 0xffffff00u; return __uint_as_float((o >> 31) ? (o ^ 0x80000000u) : ~o); }();
#pragma unroll
    for (int k = 0; k < 16; ++k) {
      const unsigned key = C0[k]; const unsigned o = key & 0xffffff00u;
      const float val = __uint_as_float((o >> 31) ? (o ^ 0x80000000u) : ~o);
      const int pos = 255 - (int)(key & 255u);
      te[k] = (int)(lut4(W1, pos >> 4) * 128u + lut4(W2, pos & 15));
      e[k] = __expf(val - tv0); sum += e[k];
    }
    const float inv = 1.f / sum;
    int4* ep = reinterpret_cast<int4*>(Eidx + ((long)t * 8 + h) * 16);
    float4* gp = reinterpret_cast<float4*>(G + ((long)t * 8 + h) * 16);
#pragma unroll
    for (int k = 0; k < 4; ++k) {
      ep[k] = make_int4(te[4 * k], te[4 * k + 1], te[4 * k + 2], te[4 * k + 3]);
      gp[k] = make_float4(e[4 * k] * inv, e[4 * k + 1] * inv, e[4 * k + 2] * inv, e[4 * k + 3] * inv);
    }
  }
}

DI int dpp_row_sum_i(int v) {
  v += __builtin_amdgcn_update_dpp(0, v, 0xB1, 0xF, 0xF, true);
  v += __builtin_amdgcn_update_dpp(0, v, 0x4E, 0xF, 0xF, true);
  v += __builtin_amdgcn_update_dpp(0, v, 0x141, 0xF, 0xF, true);
  v += __builtin_amdgcn_update_dpp(0, v, 0x140, 0xF, 0xF, true);
  return v;
}
DI int wave_sum_i(int v) { v = dpp_row_sum_i(v); return __builtin_amdgcn_readlane(v, 0) + __builtin_amdgcn_readlane(v, 16) + __builtin_amdgcn_readlane(v, 32) + __builtin_amdgcn_readlane(v, 48); }

DI void phase11a(const Params& P, char* smem_all) {
  char* ws = P.ws;
  const char* Uq = ws + OFF_UQ; const float* Us = (const float*)(ws + OFF_US); const float* Vs = (const float*)(ws + OFF_VS);
  const int* Eidx = (const int*)(ws + OFF_EIDX); const float* G = (const float*)(ws + OFF_G);
  const char* xq = ws + OFF_XQ; const float* sxp = (const float*)(ws + OFF_SX);
  float* W2 = (float*)(ws + OFF_W2); int* E2 = (int*)(ws + OFF_E2);
  const int j = RBLK & 7, lane = RTID & 63, wslot = (RBLK >> 3) * 8 + (RTID >> 6), nw = (RGRID >> 3) * 8;
  const int l16 = lane & 15, rg = lane >> 4;
  uint2* lst = (uint2*)(smem_all + (RTID >> 6) * 1024);
  int nE0 = Eidx[(long)wslot * 128 + lane], nE1 = Eidx[(long)wslot * 128 + 64 + lane];
  float nG0 = G[(long)wslot * 128 + lane], nG1 = G[(long)wslot * 128 + 64 + lane];
  uint4 nx[4];
#pragma unroll
  for (int c = 0; c < 4; ++c) nx[c] = *reinterpret_cast<const uint4*>(xq + (long)wslot * 1024 + (c * 16 + l16) * 16);
  float nsx = sxp[wslot];
  for (int t = wslot; t < NTOK; t += nw) {
    const int E0 = nE0, E1 = nE1; const float G0 = nG0, G1 = nG1, sx = nsx;
    uint4 xr[4];
#pragma unroll
    for (int c = 0; c < 4; ++c) xr[c] = nx[c];
    bool pf = false;
    const int tn = t + nw < NTOK ? t + nw : t;
    if (j == 0) { E2[(long)t * 128 + (lane & 7) * 16 + (lane >> 3)] = E0; E2[(long)t * 128 + (lane & 7) * 16 + 8 + (lane >> 3)] = E1; }
    const bool in0 = (E0 >> 11) == j, in1 = (E1 >> 11) == j;
    const unsigned long long m0 = __ballot(in0), m1 = __ballot(in1);
    const int c0 = __popcll(m0), cnt = c0 + __popcll(m1);
    const int r0 = __builtin_amdgcn_mbcnt_hi((unsigned)(m0 >> 32), __builtin_amdgcn_mbcnt_lo((unsigned)m0, 0u));
    const int r1 = c0 + __builtin_amdgcn_mbcnt_hi((unsigned)(m1 >> 32), __builtin_amdgcn_mbcnt_lo((unsigned)m1, 0u));
    if (in0) lst[r0] = make_uint2((unsigned)E0 | ((unsigned)lane << 14), __float_as_uint(G0));
    if (in1) lst[r1] = make_uint2((unsigned)E1 | ((unsigned)(64 + lane) << 14), __float_as_uint(G1));
    for (int g0 = 0; g0 < cnt; g0 += 24) {
      const int rem = cnt - g0, ng = rem >= 24 ? 6 : (rem + 3) >> 2;
      int el[6], pl[6]; float gl[6];
#pragma unroll
      for (int gi = 0; gi < 6; ++gi) {
        const int idx = g0 + 4 * gi + rg; const bool ok = idx < cnt;
        const uint2 en = lst[ok ? idx : 0];
        el[gi] = ok ? (int)(en.x & 16383u) : 0; pl[gi] = ok ? (int)(en.x >> 14) : -1; gl[gi] = ok ? __uint_as_float(en.y) : 0.f;
      }
      uint4 u[6][4]; float su[6], sv[6];
#pragma unroll
      for (int gi = 0; gi < 6; ++gi) {
        if (gi < ng) {
          const char* rowp = Uq + (long)el[gi] * 1024 + l16 * 16;
#pragma unroll
          for (int c = 0; c < 4; ++c) u[gi][c] = *reinterpret_cast<const uint4*>(rowp + c * 256);
          su[gi] = Us[el[gi]]; sv[gi] = Vs[el[gi]];
        }
      }
      if (!pf) {
        pf = true;
        nE0 = Eidx[(long)tn * 128 + lane]; nE1 = Eidx[(long)tn * 128 + 64 + lane];
        nG0 = G[(long)tn * 128 + lane]; nG1 = G[(long)tn * 128 + 64 + lane];
#pragma unroll
        for (int c = 0; c < 4; ++c) nx[c] = *reinterpret_cast<const uint4*>(xq + (long)tn * 1024 + (c * 16 + l16) * 16);
        nsx = sxp[tn];
      }
#pragma unroll
      for (int gi = 0; gi < 6; ++gi) {
        if (gi < ng) {
          int d = 0;
#pragma unroll
          for (int c = 0; c < 4; ++c) {
            d = __builtin_amdgcn_sdot4((int)u[gi][c].x, (int)xr[c].x, d, false);
            d = __builtin_amdgcn_sdot4((int)u[gi][c].y, (int)xr[c].y, d, false);
            d = __builtin_amdgcn_sdot4((int)u[gi][c].z, (int)xr[c].z, d, false);
            d = __builtin_amdgcn_sdot4((int)u[gi][c].w, (int)xr[c].w, d, false);
          }
          d = dpp_row_sum_i(d);
          const float dot = (float)d * (su[gi] * sx);
          const float w = gl[gi] * gelu_t(dot) * sv[gi];
          const int p = pl[gi];
          if (l16 == 0 && p >= 0) W2[(long)t * 128 + (p & 7) * 16 + (p >> 3)] = w;
        }
      }
    }
    if (!pf) {
      nE0 = Eidx[(long)tn * 128 + lane]; nE1 = Eidx[(long)tn * 128 + 64 + lane];
      nG0 = G[(long)tn * 128 + lane]; nG1 = G[(long)tn * 128 + 64 + lane];
#pragma unroll
      for (int c = 0; c < 4; ++c) nx[c] = *reinterpret_cast<const uint4*>(xq + (long)tn * 1024 + (c * 16 + l16) * 16);
      nsx = sxp[tn];
    }
  }
}

DI float dpp_row_sum_f(float v) {
  v += __int_as_float(__builtin_amdgcn_update_dpp(0, __float_as_int(v), 0xB1, 0xF, 0xF, true));
  v += __int_as_float(__builtin_amdgcn_update_dpp(0, __float_as_int(v), 0x4E, 0xF, 0xF, true));
  v += __int_as_float(__builtin_amdgcn_update_dpp(0, __float_as_int(v), 0x141, 0xF, 0xF, true));
  v += __int_as_float(__builtin_amdgcn_update_dpp(0, __float_as_int(v), 0x140, 0xF, 0xF, true));
  return v;
}
DI void phase11b(const Params& P, char* smem_all) {
  char* ws = P.ws;
  const char* Vq = ws + OFF_VQ;
  const float* W2 = (const float*)(ws + OFF_W2); const int* E2 = (const int*)(ws + OFF_E2);
  _Float16* Zp = (_Float16*)(ws + OFF_ZP);
  const int j = RBLK & 7, lane = RTID & 63, wv = RTID >> 6, wslot = (RBLK >> 3) * 8 + wv, nw = (RGRID >> 3) * 8;
  float* red = (float*)(smem_all + wv * 4096);
  const char* vbase = Vq + (long)j * 16384 * 128 + (lane & 7) * 16;
  const int g8 = lane >> 3;
  int4 en[4]; float4 wn[4];
  auto load_list = [&](int t) {
#pragma unroll
    for (int k = 0; k < 4; ++k) {
      en[k] = *reinterpret_cast<const int4*>(E2 + (long)t * 128 + g8 * 16 + 4 * k);
      wn[k] = *reinterpret_cast<const float4*>(W2 + (long)t * 128 + g8 * 16 + 4 * k);
    }
  };
  auto gather = [&](uint4 (&v)[16], float (&w)[16]) {
#pragma unroll
    for (int k = 0; k < 4; ++k) {
      v[4 * k] = *reinterpret_cast<const uint4*>(vbase + (long)en[k].x * 128); v[4 * k + 1] = *reinterpret_cast<const uint4*>(vbase + (long)en[k].y * 128);
      v[4 * k + 2] = *reinterpret_cast<const uint4*>(vbase + (long)en[k].z * 128); v[4 * k + 3] = *reinterpret_cast<const uint4*>(vbase + (long)en[k].w * 128);
      w[4 * k] = wn[k].x; w[4 * k + 1] = wn[k].y; w[4 * k + 2] = wn[k].z; w[4 * k + 3] = wn[k].w;
    }
  };
  auto reduce_store = [&](const uint4 (&v)[16], const float (&w)[16], int t) {
    typedef float f2 __attribute__((ext_vector_type(2)));
    f2 acc[8]; float wl = 0.f;
#pragma unroll
    for (int k = 0; k < 8; ++k) acc[k] = f2{0.f, 0.f};
#pragma unroll
    for (int r = 0; r < 16; ++r) {
      wl += w[r];
      const f2 w2 = f2{w[r], w[r]};
      const unsigned vw[4] = {v[r].x, v[r].y, v[r].z, v[r].w};
#pragma unroll
      for (int k = 0; k < 4; ++k) {
        acc[2 * k + 0] = __builtin_elementwise_fma(w2, f2{(float)(vw[k] & 0xffu), (float)((vw[k] >> 8) & 0xffu)}, acc[2 * k + 0]);
        acc[2 * k + 1] = __builtin_elementwise_fma(w2, f2{(float)((vw[k] >> 16) & 0xffu), (float)(vw[k] >> 24)}, acc[2 * k + 1]);
      }
    }
    const float rsum = dpp_row_sum_f(wl);
    const float wsum = (__int_as_float(__builtin_amdgcn_readlane(__float_as_int(rsum), 0)) + __int_as_float(__builtin_amdgcn_readlane(__float_as_int(rsum), 16)) +
                        __int_as_float(__builtin_amdgcn_readlane(__float_as_int(rsum), 32)) + __int_as_float(__builtin_amdgcn_readlane(__float_as_int(rsum), 48))) * 0.125f;
#pragma unroll
    for (int k = 0; k < 4; ++k) *reinterpret_cast<float4*>(red + g8 * 128 + (lane & 7) * 16 + 4 * k) = make_float4(acc[2 * k][0], acc[2 * k][1], acc[2 * k + 1][0], acc[2 * k + 1][1]);
    float2 s = make_float2(0.f, 0.f);
#pragma unroll
    for (int g = 0; g < 8; ++g) { const float2 a = *reinterpret_cast<const float2*>(red + g * 128 + 2 * lane); s.x += a.x; s.y += a.y; }
    h2 zo; zo[0] = (_Float16)(s.x - 128.f * wsum); zo[1] = (_Float16)(s.y - 128.f * wsum);
    *reinterpret_cast<h2*>(Zp + (long)t * 1024 + j * 128 + 2 * lane) = zo;
  };
  auto clampt = [&](int t) { return t < NTOK ? t : wslot; };
  uint4 vA[16], vB[16]; float wA[16], wB[16];
  load_list(wslot); gather(vA, wA);
  load_list(clampt(wslot + nw));
  for (int t = wslot; t < NTOK; t += 2 * nw) {
    gather(vB, wB);
    load_list(clampt(t + 2 * nw));
    reduce_store(vA, wA, t);
    gather(vA, wA);
    load_list(clampt(t + 3 * nw));
    if (t + nw < NTOK) reduce_store(vB, wB, t + nw);
  }
}

DI void phase11c(const Params& P) {
  char* ws = P.ws;
  const _Float16* h1h = (const _Float16*)(ws + OFF_H1H); const _Float16* Zp = (const _Float16*)(ws + OFF_ZP);
  const int wid = VT >> 6, lane = VT & 63;
  float4 gg[4], bb[4];
#pragma unroll
  for (int k = 0; k < 4; ++k) { gg[k] = *reinterpret_cast<const float4*>(P.ln2g + lane * 16 + k * 4); bb[k] = *reinterpret_cast<const float4*>(P.ln2b + lane * 16 + k * 4); }
  const int t0 = VB * 4 + wid, tstep = NVB * 4;
  h8 nx0, nx1, na0, na1;
  {
    const int tt = t0 < NTOK ? t0 : 0;
    nx0 = *reinterpret_cast<const h8*>(h1h + (long)tt * 1024 + lane * 16); nx1 = *reinterpret_cast<const h8*>(h1h + (long)tt * 1024 + lane * 16 + 8);
    na0 = *reinterpret_cast<const h8*>(Zp + (long)tt * 1024 + lane * 16); na1 = *reinterpret_cast<const h8*>(Zp + (long)tt * 1024 + lane * 16 + 8);
  }
  for (int t = t0; t < NTOK; t += tstep) {
    const h8 x0 = nx0, x1 = nx1, a0 = na0, a1 = na1;
    {
      const int tn = t + tstep < NTOK ? t + tstep : t;
      nx0 = *reinterpret_cast<const h8*>(h1h + (long)tn * 1024 + lane * 16); nx1 = *reinterpret_cast<const h8*>(h1h + (long)tn * 1024 + lane * 16 + 8);
      na0 = *reinterpret_cast<const h8*>(Zp + (long)tn * 1024 + lane * 16); na1 = *reinterpret_cast<const h8*>(Zp + (long)tn * 1024 + lane * 16 + 8);
    }
    float z[16]; float s = 0.f;
#pragma unroll
    for (int k = 0; k < 8; ++k) { z[k] = (float)a0[k] + ALPHA * (float)x0[k]; z[8 + k] = (float)a1[k] + ALPHA * (float)x1[k]; }
#pragma unroll
    for (int k = 0; k < 16; ++k) s += z[k];
    const float mu = wave_sum(s) * (1.f / 1024.f);
    float q = 0.f;
#pragma unroll
    for (int k = 0; k < 16; ++k) { const float d = z[k] - mu; q += d * d; }
    const float rstd = rsqrtf(wave_sum(q) * (1.f / 1024.f) + 1e-5f);
#pragma unroll
    for (int k = 0; k < 4; ++k) {
      float4 o;
      o.x = (z[4 * k] - mu) * rstd * gg[k].x + bb[k].x; o.y = (z[4 * k + 1] - mu) * rstd * gg[k].y + bb[k].y;
      o.z = (z[4 * k + 2] - mu) * rstd * gg[k].z + bb[k].z; o.w = (z[4 * k + 3] - mu) * rstd * gg[k].w + bb[k].w;
      *reinterpret_cast<float4*>(P.out + (long)t * 1024 + lane * 16 + k * 4) = o;
    }
  }
}

#define XB_TMO      128
#define XB_XCNT(j)  (256  + 64 * (j))
#define XB_XSUB(j)  (1280 + 64 * (j))
#define XB_XGEN(j)  (2304 + 64 * (j))
#define XB_TOP      3328
#define XB_TOPGEN   3392
#define XCD_BAR_WORDS 3456
#define XB_SPIN_CAP (1u << 18)
#define LAS __attribute__((address_space(3)))

DI unsigned xb_ld(unsigned* p)              { return __hip_atomic_load(p, __ATOMIC_RELAXED, __HIP_MEMORY_SCOPE_AGENT); }
DI unsigned xb_add(unsigned* p, unsigned v) { return __hip_atomic_fetch_add(p, v, __ATOMIC_RELAXED, __HIP_MEMORY_SCOPE_AGENT); }
DI unsigned xb_xcc_id() { return (unsigned)__builtin_amdgcn_s_getreg((3 << 11) | 20) & 0xFu; }
#define XB_SPIN(cond, bar) do { unsigned _sp = 0; while (cond) { __builtin_amdgcn_s_sleep(1); \
    if ((++_sp & 255u) == 0u) { if (xb_ld(&(bar)[XB_TMO])) break; if (_sp > XB_SPIN_CAP) { atomicAdd(&(bar)[XB_TMO], 1u); break; } } } } while (0)

struct XcdBarrier {
    unsigned* bar; unsigned x;
    volatile LAS unsigned* st;
};

DI XcdBarrier xcd_barrier_post(unsigned* bar, volatile LAS unsigned* st) {
    XcdBarrier b; b.bar = bar; b.x = xb_xcc_id(); b.st = st;
    if (threadIdx.x == 0) (void)xb_add(&bar[XB_XCNT(b.x)], 1u);
    return b;
}
DI void xcd_barrier_complete(unsigned* bar, unsigned x, unsigned& nloc, unsigned& nx) {
    const unsigned G = gridDim.x * gridDim.y * gridDim.z;
    unsigned sum, cnt, mine, sp = 0u;
    for (;;) {
        sum = 0u; cnt = 0u; mine = 0u;
#pragma unroll
        for (unsigned j = 0; j < 16; ++j) { const unsigned c = xb_ld(&bar[XB_XCNT(j)]); sum += c; cnt += (c > 0u) ? 1u : 0u; mine = (j == x) ? c : mine; }
        if (sum == G) break;
        __builtin_amdgcn_s_sleep(1);
        if ((++sp & 255u) == 0u) { if (xb_ld(&bar[XB_TMO])) break; if (sp > XB_SPIN_CAP) { atomicAdd(&bar[XB_TMO], 1u); break; } }
    }
    nloc = mine > 0u ? mine : 1u; nx = cnt > 0u ? cnt : 1u;
}

DI void xcd_barrier(const XcdBarrier& b) {
    asm volatile("s_waitcnt vmcnt(0)" ::: "memory");
    __syncthreads();
    if (threadIdx.x == 0) {
        unsigned* bar = b.bar;
        __builtin_amdgcn_s_waitcnt(0);
        unsigned nloc = b.st[0], nx = b.st[1];
        if (nloc == 0u) { xcd_barrier_complete(bar, b.x, nloc, nx); b.st[0] = nloc; b.st[1] = nx; }
        const unsigned old = xb_add(&bar[XB_XSUB(b.x)], 1u);
        const unsigned gen = old / nloc;
        if (old + 1u == (gen + 1u) * nloc) {
            __builtin_amdgcn_fence(__ATOMIC_RELEASE, "agent");
            asm volatile("s_waitcnt vmcnt(0)" ::: "memory");
            const unsigned og = xb_add(&bar[XB_TOP], 1u);
            const unsigned tg = og / nx;
            if (og + 1u == (tg + 1u) * nx) xb_add(&bar[XB_TOPGEN], 1u);
            else XB_SPIN(xb_ld(&bar[XB_TOPGEN]) == tg, bar);
            __builtin_amdgcn_fence(__ATOMIC_ACQUIRE, "agent");
            xb_add(&bar[XB_XGEN(b.x)], 1u);
            asm volatile("s_waitcnt vmcnt(0)" ::: "memory");
        } else {
            XB_SPIN(xb_ld(&bar[XB_XGEN(b.x)]) == gen, bar);
            __builtin_amdgcn_fence(__ATOMIC_ACQUIRE, "agent");
            asm volatile("s_waitcnt vmcnt(0)" ::: "memory");
        }
    }
    __syncthreads();
}


__global__ void __launch_bounds__(512, 1) k_mega(Params P) {
  extern __shared__ __attribute__((aligned(16))) char smem_all[];
  char* smem = smem_all + VHALF * VLDS;
  cg::grid_group grid = cg::this_grid();
  volatile LAS unsigned* xb_st = (volatile LAS unsigned*)(smem_all + 2 * VLDS);
  if (RTID == 0) { xb_st[0] = 0u; xb_st[1] = 0u; xb_st[2] = 0u; xb_st[3] = 0u; }
  __syncthreads();
  const XcdBarrier xb = xcd_barrier_post((unsigned*)(P.ws + OFF_BAR), xb_st);
  if (P.out == nullptr) grid.sync();
  phase0(P, smem); xcd_barrier(xb);
  if (PROBE_DUP == 0) { grid.sync(); phase0(P, smem); grid.sync(); }
  phase1(P, smem_all); xcd_barrier(xb);
  if (PROBE_DUP == 1) { grid.sync(); phase1(P, smem_all); grid.sync(); }
  phase2(P, smem); xcd_barrier(xb);
  if (PROBE_DUP == 2) { grid.sync(); phase2(P, smem); grid.sync(); }
  phase3(P, smem); xcd_barrier(xb);
  if (PROBE_DUP == 3) { grid.sync(); phase3(P, smem); grid.sync(); }
  phase4(P, smem); xcd_barrier(xb);
  if (PROBE_DUP == 4) { grid.sync(); phase4(P, smem); grid.sync(); }
  phase5(P, smem); xcd_barrier(xb);
  if (PROBE_DUP == 5) { grid.sync(); phase5(P, smem); grid.sync(); }
  phase6(P, smem_all); xcd_barrier(xb);
  if (PROBE_DUP == 6) { grid.sync(); phase6(P, smem_all); grid.sync(); }
  phase7(P, smem); xcd_barrier(xb);
  if (PROBE_DUP == 7) { grid.sync(); phase7(P, smem); grid.sync(); }
  phase8(P, smem_all); xcd_barrier(xb);
  if (PROBE_DUP == 8) { grid.sync(); phase8(P, smem_all); grid.sync(); }
  phase9(P, smem); xcd_barrier(xb);
  if (PROBE_DUP == 9) { grid.sync(); phase9(P, smem); grid.sync(); }
  phase10(P, smem); xcd_barrier(xb);
  if (PROBE_DUP == 10) { grid.sync(); phase10(P, smem); grid.sync(); }
  phase11a(P, smem_all); xcd_barrier(xb);
  if (PROBE_DUP == 111) { phase11a(P, smem_all); grid.sync(); }
  phase11b(P, smem_all); xcd_barrier(xb);
  if (PROBE_DUP == 112) { phase11b(P, smem_all); grid.sync(); }
  phase11c(P);
  if (PROBE_DUP == 113) { grid.sync(); phase11c(P); }
}

extern "C" void kernel_launch(void* const* d_in, const int* in_sizes, int n_in, void* d_out, int out_size, void* d_ws, size_t ws_size, hipStream_t stream) {
  if (ws_size < WS_NEED) { fprintf(stderr, "workspace too small: %zu\n", ws_size); return; }
  Params P{};
  P.x = (const float*)d_in[0]; P.w_in = (const float*)d_in[1]; P.a_re = (const float*)d_in[2]; P.a_im = (const float*)d_in[3];
  P.log_dt = (const float*)d_in[4]; P.b_re = (const float*)d_in[5]; P.b_im = (const float*)d_in[6]; P.c_re = (const float*)d_in[7];
  P.c_im = (const float*)d_in[8]; P.dsk = (const float*)d_in[9]; P.w_glu = (const float*)d_in[10]; P.w_out = (const float*)d_in[11];
  P.ln1g = (const float*)d_in[12]; P.ln1b = (const float*)d_in[13]; P.w_q = (const float*)d_in[14]; P.subk = (const float*)d_in[15];
  P.pu = (const float*)d_in[16]; P.pv = (const float*)d_in[17]; P.ln2g = (const float*)d_in[18]; P.ln2b = (const float*)d_in[19];
  P.out = (float*)d_out; P.ws = (char*)d_ws;
  static int grid_blocks = 0;
  if (!grid_blocks) {
    int dev = 0, cus = 0, per_cu = 0;
    hipGetDevice(&dev);
    hipDeviceGetAttribute(&cus, hipDeviceAttributeMultiprocessorCount, dev);
    hipFuncSetAttribute((const void*)k_mega, hipFuncAttributeMaxDynamicSharedMemorySize, LDS_BYTES);
    hipOccupancyMaxActiveBlocksPerMultiprocessor(&per_cu, k_mega, 512, LDS_BYTES);
    if (per_cu > 1) per_cu = 1;
    grid_blocks = (cus * per_cu) & ~7;
  }
  hipMemsetAsync((char*)d_ws + OFF_BAR, 0, XCD_BAR_WORDS * sizeof(unsigned), stream);
  void* args[] = {&P};
  hipError_t e = hipLaunchCooperativeKernel((void*)k_mega, dim3(grid_blocks), dim3(512), args, LDS_BYTES, stream);
  if (e != hipSuccess) fprintf(stderr, "cooperative launch failed: %s (grid %d)\n", hipGetErrorString(e), grid_blocks);
}
```

```cpp
#include <hip/hip_runtime.h>
#include <hip/hip_cooperative_groups.h>
#include <cstdio>
#include <cstdint>
namespace cg = cooperative_groups;

#ifndef PROBE_DUP
#define PROBE_DUP -1
#endif
#define DI __device__ __forceinline__
#define RBLK ((int)blockIdx.x)
#define RGRID ((int)gridDim.x)
#define RTID ((int)threadIdx.x)
#define VHALF (RTID >> 8)
#define VT (RTID & 255)
#define VB (RBLK * 2 + VHALF)
#define NVB (RGRID * 2)
constexpr int VLDS = 70912;

typedef unsigned short u16;
using bf16x8 = __attribute__((ext_vector_type(8))) short;
using f32x4  = __attribute__((ext_vector_type(4))) float;
using f32x16 = __attribute__((ext_vector_type(16))) float;
typedef _Float16 h2 __attribute__((ext_vector_type(2)));
typedef _Float16 h8 __attribute__((ext_vector_type(8)));

constexpr int NTOK = 32768, DM = 1024, SEQ = 8192;
constexpr float ALPHA = 1.189207115002721f;
constexpr size_t MB = 1u << 20;
constexpr size_t OFF_QB = 0, OFF_KB = 32 * MB, OFF_UH = 0, OFF_VH = 32 * MB;
constexpr size_t OFF_UQ = 0, OFF_VQ = 16 * MB, OFF_US = 32 * MB, OFF_VS = 33 * MB;
constexpr size_t OFF_XQ = 400 * MB, OFF_SX = 432 * MB, OFF_W2 = 434 * MB, OFF_E2 = 450 * MB, OFF_ZP = 160 * MB;
constexpr size_t OFF_XB = 64 * MB, OFF_YB = 64 * MB, OFF_H1H = 64 * MB;
constexpr size_t OFF_OPART = 128 * MB, OFF_LSE = 256 * MB, OFF_Z1 = 128 * MB, OFF_QP = 128 * MB, OFF_EIDX = 128 * MB, OFF_G = 144 * MB;
constexpr size_t OFF_WY = 260 * MB, OFF_WST = 332 * MB, OFF_SLOC = 340 * MB, OFF_LIST = 348 * MB;
constexpr size_t OFF_H1B = 256 * MB, OFF_ST = 256 * MB;
constexpr size_t OFF_WINT = 384 * MB, OFF_WQT = 388 * MB, OFF_WOT = 392 * MB, OFF_WGT = 394 * MB, OFF_SKB = 394 * MB + 512 * 1024;
constexpr size_t OFF_KTAB = 395 * MB, OFF_KMEAN = 397 * MB, OFF_GCOUNT = 397 * MB + 256 * 1024;
constexpr size_t OFF_VT = 400 * MB, OFF_CAT = 400 * MB, OFF_UG = 464 * MB;
constexpr size_t WS_NEED = 500 * MB;
constexpr size_t OFF_BAR = 398 * MB;
constexpr int UGLD = 1152;
constexpr int LDS_BYTES = 2 * 70912 + 16;

struct Params {
  const float *x, *w_in, *a_re, *a_im, *log_dt, *b_re, *b_im, *c_re, *c_im, *dsk, *w_glu, *w_out, *ln1g, *ln1b, *w_q, *subk, *pu, *pv, *ln2g, *ln2b;
  float* out;
  char* ws;
};

typedef __bf16 bf2_t __attribute__((ext_vector_type(2)));
typedef float f2_t __attribute__((ext_vector_type(2)));
DI unsigned pack2bf(float a, float b) { const f2_t v = {a, b}; return __builtin_bit_cast(unsigned, __builtin_convertvector(v, bf2_t)); }
DI u16 f2bf(float x) { return (u16)(pack2bf(x, 0.f) & 0xffffu); }
DI float bf2f(u16 b) { return __uint_as_float(((unsigned)b) << 16); }
DI float gelu_t(float x) { float u = 0.7978845608028654f * (x + 0.044715f * x * x * x); float e = __expf(2.f * u); float t = 1.f - 2.f / (1.f + e); return 0.5f * x * (1.f + t); }
DI float2 cmul(float2 a, float2 b) { return make_float2(a.x * b.x - a.y * b.y, a.x * b.y + a.y * b.x); }
DI float2 cexpf2(float re, float im) { float e = expf(re); float s, c; sincosf(im, &s, &c); return make_float2(e * c, e * s); }
DI float dpp_row_sum_f0(float v) {
  v += __int_as_float(__builtin_amdgcn_update_dpp(0, __float_as_int(v), 0xB1, 0xF, 0xF, true));
  v += __int_as_float(__builtin_amdgcn_update_dpp(0, __float_as_int(v), 0x4E, 0xF, 0xF, true));
  v += __int_as_float(__builtin_amdgcn_update_dpp(0, __float_as_int(v), 0x141, 0xF, 0xF, true));
  v += __int_as_float(__builtin_amdgcn_update_dpp(0, __float_as_int(v), 0x140, 0xF, 0xF, true));
  return v;
}
DI float rl_f(float v, int l) { return __int_as_float(__builtin_amdgcn_readlane(__float_as_int(v), l)); }
DI float wave_sum(float v) { v = dpp_row_sum_f0(v); return (rl_f(v, 0) + rl_f(v, 16)) + (rl_f(v, 32) + rl_f(v, 48)); }
DI float wave_max(float v) {
  v = fmaxf(v, __int_as_float(__builtin_amdgcn_update_dpp(0, __float_as_int(v), 0xB1, 0xF, 0xF, true)));
  v = fmaxf(v, __int_as_float(__builtin_amdgcn_update_dpp(0, __float_as_int(v), 0x4E, 0xF, 0xF, true)));
  v = fmaxf(v, __int_as_float(__builtin_amdgcn_update_dpp(0, __float_as_int(v), 0x141, 0xF, 0xF, true)));
  v = fmaxf(v, __int_as_float(__builtin_amdgcn_update_dpp(0, __float_as_int(v), 0x140, 0xF, 0xF, true)));
  return fmaxf(fmaxf(rl_f(v, 0), rl_f(v, 16)), fmaxf(rl_f(v, 32), rl_f(v, 48)));
}

template <bool SWAP, class Epi>
DI void gemm_tile(const u16* __restrict__ Ag, long lda, const u16* __restrict__ Bg, long ldb, int ka0, int ka1, int kb0, int kb1, char* shm, Epi&& epi) {
  const int tid = VT, wid = tid >> 6, lane = tid & 63, wr = wid >> 1, wc = wid & 1, fr = lane & 15, fq = lane >> 4;
  const int na = ka1 - ka0, nk = na + (kb1 - kb0);
  f32x4 acc[4][4];
#pragma unroll
  for (int m = 0; m < 4; ++m)
#pragma unroll
    for (int n = 0; n < 4; ++n) acc[m][n] = f32x4{0.f, 0.f, 0.f, 0.f};
  auto stage = [&](int buf, int kt) {
    char* SA = shm + buf * 32768; char* SB = SA + 16384;
#pragma unroll
    for (int i = 0; i < 4; ++i) {
      const int q = i * 256 + tid, r = q >> 3, c16 = (q & 7) ^ ((r >> 1) & 7);
      __builtin_amdgcn_global_load_lds((const unsigned*)(Ag + (long)r * lda + kt * 64 + c16 * 8), (__attribute__((address_space(3))) unsigned*)(SA + q * 16), 16, 0, 0);
      __builtin_amdgcn_global_load_lds((const unsigned*)(Bg + (long)r * ldb + kt * 64 + c16 * 8), (__attribute__((address_space(3))) unsigned*)(SB + q * 16), 16, 0, 0);
    }
  };
  stage(0, ka0 < ka1 ? ka0 : kb0);
  for (int i = 0; i < nk; ++i) {
    asm volatile("s_waitcnt vmcnt(0)" ::: "memory");
    __syncthreads();
    if (i + 1 < nk) { const int j = i + 1; stage(j & 1, j < na ? ka0 + j : kb0 + (j - na)); }
    const char* SA = shm + (i & 1) * 32768; const char* SB = SA + 16384;
#pragma unroll
    for (int ks = 0; ks < 2; ++ks) {
      bf16x8 At[4], Bt[4];
#pragma unroll
      for (int m = 0; m < 4; ++m) {
        const int ra = wr * 64 + m * 16 + fr, rb = wc * 64 + m * 16 + fr;
        At[m] = *reinterpret_cast<const bf16x8*>(SA + ra * 128 + (((ks * 4 + fq) ^ ((ra >> 1) & 7)) * 16));
        Bt[m] = *reinterpret_cast<const bf16x8*>(SB + rb * 128 + (((ks * 4 + fq) ^ ((rb >> 1) & 7)) * 16));
      }
#pragma unroll
      for (int m = 0; m < 4; ++m)
#pragma unroll
        for (int n = 0; n < 4; ++n) acc[m][n] = SWAP ? __builtin_amdgcn_mfma_f32_16x16x32_bf16(Bt[n], At[m], acc[m][n], 0, 0, 0) : __builtin_amdgcn_mfma_f32_16x16x32_bf16(At[m], Bt[n], acc[m][n], 0, 0, 0);
    }
  }
  __syncthreads();
#pragma unroll
  for (int m = 0; m < 4; ++m)
#pragma unroll
    for (int n = 0; n < 4; ++n) { if (SWAP) epi(wr * 64 + m * 16 + fr, wc * 64 + n * 16 + fq * 4, acc[m][n]); else epi(wr * 64 + m * 16 + fq * 4, wc * 64 + n * 16 + fr, acc[m][n]); }
}

template <class Epi>
DI void gemm_tile256(const u16* __restrict__ Ag, long lda, const u16* __restrict__ Bg, long ldb, int nk, char* shm, Epi&& epi) {
  const int tid = RTID, wid = tid >> 6, lane = tid & 63, wr = wid >> 2, wc = wid & 3, fr = lane & 15, fq = lane >> 4;
  f32x4 acc[8][4];
#pragma unroll
  for (int m = 0; m < 8; ++m)
#pragma unroll
    for (int n = 0; n < 4; ++n) acc[m][n] = f32x4{0.f, 0.f, 0.f, 0.f};
  const int q0 = tid, q1 = 512 + tid;
  const int r0 = q0 >> 2, r1 = q1 >> 2, c0 = (q0 & 3) ^ ((r0 >> 2) & 3), c1 = (q1 & 3) ^ ((r1 >> 2) & 3);
  const u16* a0 = Ag + (long)r0 * lda + c0 * 8; const u16* a1 = Ag + (long)r1 * lda + c1 * 8;
  const u16* b0 = Bg + (long)r0 * ldb + c0 * 8; const u16* b1 = Bg + (long)r1 * ldb + c1 * 8;
  auto stage = [&](int j) {
    char* SA = shm + (j & 3) * 32768; char* SB = SA + 16384;
    __builtin_amdgcn_global_load_lds((const unsigned*)(a0 + j * 32), (__attribute__((address_space(3))) unsigned*)(SA + q0 * 16), 16, 0, 0);
    __builtin_amdgcn_global_load_lds((const unsigned*)(a1 + j * 32), (__attribute__((address_space(3))) unsigned*)(SA + q1 * 16), 16, 0, 0);
    __builtin_amdgcn_global_load_lds((const unsigned*)(b0 + j * 32), (__attribute__((address_space(3))) unsigned*)(SB + q0 * 16), 16, 0, 0);
    __builtin_amdgcn_global_load_lds((const unsigned*)(b1 + j * 32), (__attribute__((address_space(3))) unsigned*)(SB + q1 * 16), 16, 0, 0);
  };
  __syncthreads();
  stage(0);
  if (nk > 1) stage(1);
  if (nk > 2) stage(2);
  for (int i = 0; i < nk; ++i) {
    if (i + 2 < nk) asm volatile("s_waitcnt vmcnt(8)" ::: "memory");
    else if (i + 1 < nk) asm volatile("s_waitcnt vmcnt(4)" ::: "memory");
    else asm volatile("s_waitcnt vmcnt(0)" ::: "memory");
    __builtin_amdgcn_s_barrier();
    __builtin_amdgcn_sched_barrier(0);
    const char* SA = shm + (i & 3) * 32768; const char* SB = SA + 16384;
    bf16x8 At[8], Bt[4];
#pragma unroll
    for (int n = 0; n < 4; ++n) { const int rb = wc * 64 + n * 16 + fr; Bt[n] = *reinterpret_cast<const bf16x8*>(SB + rb * 64 + ((fq ^ ((rb >> 2) & 3)) * 16)); }
#pragma unroll
    for (int m = 0; m < 8; ++m) { const int ra = wr * 128 + m * 16 + fr; At[m] = *reinterpret_cast<const bf16x8*>(SA + ra * 64 + ((fq ^ ((ra >> 2) & 3)) * 16)); }
    if (i + 3 < nk) stage(i + 3);
#pragma unroll
    for (int m = 0; m < 8; ++m)
#pragma unroll
      for (int n = 0; n < 4; ++n) acc[m][n] = __builtin_amdgcn_mfma_f32_16x16x32_bf16(Bt[n], At[m], acc[m][n], 0, 0, 0);
  }
  __syncthreads();
#pragma unroll
  for (int m = 0; m < 8; ++m)
#pragma unroll
    for (int n = 0; n < 4; ++n) epi(wr * 128 + m * 16 + fr, wc * 64 + n * 16 + fq * 4, acc[m][n]);
}

DI int xcd_tile(int q, int x, int C) { if (C >= 8) { const int cpx = C >> 3; return (q / cpx) * C + x * cpx + q % cpx; } const int rpx = 8 / C; return (q * rpx + x / C) * C + (x % C); }
#define TILE_LOOP(tile, N, C)                                                                                          \
  for (int q0_ = (RBLK >> 3) * 2, tile = 0;                                                                            \
       q0_ < (N) / 8 && ((tile = xcd_tile((q0_ + VHALF < (N) / 8 ? q0_ + VHALF : q0_), RBLK & 7, (C))), true);          \
       q0_ += (RGRID >> 3) * 2)

DI void transpose_bf16(const float* __restrict__ src, int K, int N, u16* __restrict__ dst, int vb, int nvb) {
  const long total = (long)(K / 8) * N;
  for (long idx = (long)vb * 256 + VT; idx < total; idx += (long)nvb * 256) {
    int n = (int)(idx % N), k8 = (int)(idx / N);
    unsigned w[4];
#pragma unroll
    for (int j = 0; j < 4; ++j) w[j] = pack2bf(src[(long)(k8 * 8 + 2 * j) * N + n], src[(long)(k8 * 8 + 2 * j + 1) * N + n]);
    *reinterpret_cast<uint4*>(dst + (long)n * K + k8 * 8) = make_uint4(w[0], w[1], w[2], w[3]);
  }
}
DI void cvt_bf16(const float* __restrict__ src, long n, u16* __restrict__ dst, int vb, int nvb) {
  for (long idx = (long)vb * 256 + VT; idx < n / 8; idx += (long)nvb * 256) {
    float4 a = reinterpret_cast<const float4*>(src)[idx * 2], b = reinterpret_cast<const float4*>(src)[idx * 2 + 1];
    reinterpret_cast<uint4*>(dst)[idx] = make_uint4(pack2bf(a.x, a.y), pack2bf(a.z, a.w), pack2bf(b.x, b.y), pack2bf(b.z, b.w));
  }
}
DI void cvt_f16(const float* __restrict__ src, long n, _Float16* __restrict__ dst) {
  for (long idx = (long)VB * 256 + VT; idx < n / 8; idx += (long)NVB * 256) {
    float4 a = reinterpret_cast<const float4*>(src)[idx * 2], b = reinterpret_cast<const float4*>(src)[idx * 2 + 1];
    h8 o; o[0] = (_Float16)a.x; o[1] = (_Float16)a.y; o[2] = (_Float16)a.z; o[3] = (_Float16)a.w; o[4] = (_Float16)b.x; o[5] = (_Float16)b.y; o[6] = (_Float16)b.z; o[7] = (_Float16)b.w;
    reinterpret_cast<h8*>(dst)[idx] = o;
  }
}
DI float2 ssm_f(const Params& P, int g, int p, float dt) {
  float ar = P.a_re[g * 64 + p], ai = P.a_im[g * 64 + p];
  float2 lb = cexpf2(ar * dt, ai * dt);
  float nr = lb.x - 1.f, ni = lb.y, den = ar * ar + ai * ai;
  return make_float2((nr * ar + ni * ai) / den, (ni * ar - nr * ai) / den);
}

DI void phase0(const Params& P, char* smem) {
  char* ws = P.ws;
  cvt_bf16(P.x, (long)NTOK * DM, (u16*)(ws + OFF_XB), VB, NVB);
  transpose_bf16(P.w_in, 1024, 2048, (u16*)(ws + OFF_WINT), VB, NVB);
  const long gtid = (long)VB * 256 + VT, gstride = (long)NVB * 256;
  {
    u16* Wst = (u16*)(ws + OFF_WST);
    for (long idx = gtid; idx < 32L * 64 * 64; idx += gstride) {
      const int g = (int)(idx >> 12), p = (int)(idx >> 6) & 63, j = (int)idx & 63;
      const float dt = expf(P.log_dt[g]);
      const float ar = P.a_re[g * 64 + p], ai = P.a_im[g * 64 + p];
      const float d = (float)(63 - j);
      const float2 E = cmul(cexpf2(ar * dt * d, ai * dt * d), ssm_f(P, g, p, dt));
      unsigned wr_[8], wi_[8];
#pragma unroll
      for (int q = 0; q < 8; ++q) {
        const float2 v0 = cmul(E, make_float2(P.b_re[(g * 64 + p) * 16 + 2 * q], P.b_im[(g * 64 + p) * 16 + 2 * q]));
        const float2 v1 = cmul(E, make_float2(P.b_re[(g * 64 + p) * 16 + 2 * q + 1], P.b_im[(g * 64 + p) * 16 + 2 * q + 1]));
        wr_[q] = pack2bf(v0.x, v1.x); wi_[q] = pack2bf(v0.y, v1.y);
      }
      uint4* dr = reinterpret_cast<uint4*>(Wst + ((long)g * 128 + 2 * p) * 1024 + j * 16);
      uint4* di = reinterpret_cast<uint4*>(Wst + ((long)g * 128 + 2 * p + 1) * 1024 + j * 16);
      dr[0] = make_uint4(wr_[0], wr_[1], wr_[2], wr_[3]); dr[1] = make_uint4(wr_[4], wr_[5], wr_[6], wr_[7]);
      di[0] = make_uint4(wi_[0], wi_[1], wi_[2], wi_[3]); di[1] = make_uint4(wi_[4], wi_[5], wi_[6], wi_[7]);
    }
  }
  {
    u16* Wy = (u16*)(ws + OFF_WY);
    for (long idx = gtid; idx < 32L * 64 * 64; idx += gstride) {
      const int g = (int)(idx >> 12), i = (int)(idx >> 6) & 63, p = (int)idx & 63;
      const float dt = expf(P.log_dt[g]);
      const float ar = P.a_re[g * 64 + p], ai = P.a_im[g * 64 + p];
      const float d = (float)(i + 1);
      const float2 E = cexpf2(ar * dt * d, ai * dt * d);
#pragma unroll
      for (int h = 0; h < 16; ++h) {
        const float2 z = cmul(make_float2(P.c_re[(g * 16 + h) * 64 + p], P.c_im[(g * 16 + h) * 64 + p]), E);
        *reinterpret_cast<unsigned*>(Wy + ((long)g * 1024 + i * 16 + h) * UGLD + 1024 + 2 * p) = pack2bf(z.x, -z.y);
      }
    }
  }
  {
    float* Ktab = (float*)(ws + OFF_KTAB);
    float2* Es = (float2*)smem;
    for (int item0 = RBLK * 2; item0 < 32 * 64; item0 += RGRID * 2) {
      const int item = item0 + VHALF;
      int g = item >> 6, d = item & 63, tid = VT;
      if (tid < 64) {
        float dt = expf(P.log_dt[g]);
        float ar = P.a_re[g * 64 + tid], ai = P.a_im[g * 64 + tid];
        Es[tid] = cmul(cexpf2(ar * dt * (float)d, ai * dt * (float)d), ssm_f(P, g, tid, dt));
      }
      __syncthreads();
      int h = tid >> 4, hp = tid & 15;
      float s = 0.f;
      for (int p = 0; p < 64; ++p) {
        float2 T = cmul(Es[p], make_float2(P.b_re[(g * 64 + p) * 16 + hp], P.b_im[(g * 64 + p) * 16 + hp]));
        s += P.c_re[(g * 16 + h) * 64 + p] * T.x - P.c_im[(g * 16 + h) * 64 + p] * T.y;
      }
      Ktab[((g * 64 + d) * 16 + h) * 16 + hp] = s;
      __syncthreads();
    }
  }
  {
    int* gcount = (int*)(ws + OFF_GCOUNT);
    for (long idx = gtid; idx < 1024; idx += gstride) gcount[idx] = 0;
  }
}

DI void phase1(const Params& P, char* smem) {
  char* ws = P.ws;
  const u16* xb = (const u16*)(ws + OFF_XB);
  const u16* WinT = (const u16*)(ws + OFF_WINT);
  u16* UG = (u16*)(ws + OFF_UG); u16* Qb = (u16*)(ws + OFF_QB); u16* Kb = (u16*)(ws + OFF_KB); u16* Vt = (u16*)(ws + OFF_VT);
  for (int q = RBLK >> 3; q < 128; q += RGRID >> 3) {
    const int brow = q * 256, bcol = (RBLK & 7) * 256;
    gemm_tile256(xb + (long)brow * 1024, 1024, WinT + (long)bcol * 1024, 1024, 32, smem, [&](int row, int col0, f32x4 v) {
      const int r = brow + row, c = bcol + col0;
      const uint2 pk = make_uint2(pack2bf(v[0], v[1]), pack2bf(v[2], v[3]));
      if (bcol < 512) {
        const int g = c >> 4, hp = c & 15, m = r >> 6, j = r & 63;
        *reinterpret_cast<uint2*>(UG + ((long)g * 512 + m) * UGLD + j * 16 + hp) = pk;
      } else if (bcol < 1024) {
        *reinterpret_cast<uint2*>(Qb + (long)r * 512 + (c - 512)) = pk;
      } else if (bcol < 1536) {
        *reinterpret_cast<uint2*>(Kb + (long)r * 512 + (c - 1024)) = pk;
      } else {
        const int hd = c - 1536, b = r >> 13, l = r & 8191;
#pragma unroll
        for (int j = 0; j < 4; ++j) Vt[((long)(b * 512 + hd + j)) * 8192 + l] = f2bf(v[j]);
      }
    });
  }
}

DI void phase2(const Params& P, char* smem) {
  char* ws = P.ws;
  const u16* UG = (const u16*)(ws + OFF_UG); const u16* Wst = (const u16*)(ws + OFF_WST);
  float* Sloc = (float*)(ws + OFF_SLOC);
  for (int tile0 = RBLK * 2; tile0 < 32 * 4; tile0 += RGRID * 2) {
    const int tile = tile0 + VHALF;
    const int g = tile >> 2, brow = (tile & 3) * 128;
    gemm_tile<true>(UG + ((long)g * 512 + brow) * UGLD, UGLD, Wst + (long)g * 128 * 1024, 1024, 0, 16, 0, 0, smem, [&](int row, int col0, f32x4 v) {
      *reinterpret_cast<float4*>(Sloc + ((long)g * 512 + brow + row) * 128 + col0) = make_float4(v[0], v[1], v[2], v[3]);
    });
  }
  const u16* Kb = (const u16*)(ws + OFF_KB);
  float* kmean = (float*)(ws + OFF_KMEAN);
  float* red = (float*)smem;
  for (int item0 = RBLK * 2; item0 < 1024; item0 += RGRID * 2) {
    const int item = item0 + VHALF;
    const int bh = item >> 5, n = item & 31, b = bh >> 3, h = bh & 7, tid = VT, d = tid & 63, part = tid >> 6;
    float s = 0.f;
    for (int kk = 0; kk < 64; ++kk) s += bf2f(Kb[((long)(b * 8192 + n * 256 + part * 64 + kk)) * 512 + h * 64 + d]);
    red[tid] = s;
    __syncthreads();
    if (tid < 64) kmean[(bh * 32 + n) * 64 + tid] = (red[tid] + red[tid + 64] + red[tid + 128] + red[tid + 192]) * (1.f / 256.f);
    __syncthreads();
  }
  {
    const bool part = RGRID > 64;
    if (!part || RBLK >= 64) {
      const int vb = part ? (RBLK - 64) * 2 + VHALF : VB, nvb = part ? (RGRID - 64) * 2 : NVB;
      transpose_bf16(P.w_glu, 512, 512, (u16*)(ws + OFF_WGT), vb, nvb);
      transpose_bf16(P.w_out, 1024, 1024, (u16*)(ws + OFF_WOT), vb, nvb);
      transpose_bf16(P.w_q, 1024, 2048, (u16*)(ws + OFF_WQT), vb, nvb);
      cvt_bf16(P.subk, 8 * 2 * 128 * 128, (u16*)(ws + OFF_SKB), vb, nvb);
    }
  }
}

DI void phase3(const Params& P, char* smem) {
  char* ws = P.ws;
  {
    u16* UG = (u16*)(ws + OFF_UG); const float* Sloc = (const float*)(ws + OFF_SLOC);
    for (int id = VB * 256 + VT; id < 8192; id += NVB * 256) {
      const int p = id & 63, b = (id >> 6) & 3, g = id >> 8;
      const float dt = expf(P.log_dt[g]);
      const float ar = P.a_re[g * 64 + p], ai = P.a_im[g * 64 + p];
      const float2 lamT = cexpf2(ar * dt * 64.f, ai * dt * 64.f);
      float2 s = make_float2(0.f, 0.f);
      for (int c0 = 0; c0 < 128; c0 += 16) {
        const long m0 = (long)g * 512 + b * 128 + c0;
        float2 loc[16];
#pragma unroll
        for (int k = 0; k < 16; ++k) loc[k] = *reinterpret_cast<const float2*>(Sloc + (m0 + k) * 128 + 2 * p);
#pragma unroll
        for (int k = 0; k < 16; ++k) {
          *reinterpret_cast<unsigned*>(UG + (m0 + k) * UGLD + 1024 + 2 * p) = pack2bf(s.x, s.y);
          s = cmul(lamT, s); s.x += loc[k].x; s.y += loc[k].y;
        }
      }
    }
  }
  {
    const u16* Qb = (const u16*)(ws + OFF_QB);
    const float* kmean = (const float*)(ws + OFF_KMEAN);
    int* gcount = (int*)(ws + OFF_GCOUNT);
    u16* list = (u16*)(ws + OFF_LIST);
    float* km = (float*)smem;
    int* cnt = (int*)(smem + 31 * 64 * 4);
    int* base = cnt + 32;
    for (int item0 = RBLK * 2; item0 < 1024; item0 += RGRID * 2) {
      const int item = item0 + VHALF;
      const int bh = item >> 5, own = (item & 512) ? 31 - (item & 31) : (item & 31), b = bh >> 3, h = bh & 7, tid = VT;
      const bool act = own > 0;
      if (act) for (int i = tid; i < own * 64; i += 256) km[i] = kmean[bh * 32 * 64 + i];
      if (tid < 32) cnt[tid] = 0;
      __syncthreads();
      const int l = own * 256 + tid;
      float v0 = -3e38f, v1 = -3e38f, v2 = -3e38f; int n0 = 0, n1 = 0, n2 = 0;
      if (act) {
        const u16* qrow = Qb + ((long)(b * 8192 + l)) * 512 + h * 64;
        float q[64];
#pragma unroll
        for (int c8 = 0; c8 < 8; ++c8) {
          uint4 w = *reinterpret_cast<const uint4*>(qrow + c8 * 8);
          q[c8 * 8 + 0] = __uint_as_float(w.x << 16); q[c8 * 8 + 1] = __uint_as_float(w.x & 0xffff0000u);
          q[c8 * 8 + 2] = __uint_as_float(w.y << 16); q[c8 * 8 + 3] = __uint_as_float(w.y & 0xffff0000u);
          q[c8 * 8 + 4] = __uint_as_float(w.z << 16); q[c8 * 8 + 5] = __uint_as_float(w.z & 0xffff0000u);
          q[c8 * 8 + 6] = __uint_as_float(w.w << 16); q[c8 * 8 + 7] = __uint_as_float(w.w & 0xffff0000u);
        }
        for (int n = 0; n < own; ++n) {
          float sacc = 0.f;
#pragma unroll
          for (int d = 0; d < 64; ++d) sacc += q[d] * km[n * 64 + d];
          if (sacc > v2) {
            if (sacc > v1) { v2 = v1; n2 = n1; if (sacc > v0) { v1 = v0; n1 = n0; v0 = sacc; n0 = n; } else { v1 = sacc; n1 = n; } }
            else { v2 = sacc; n2 = n; }
          }
        }
      }
      const int nsel = own < 3 ? own : 3;
      int p0 = 0, p1 = 0, p2 = 0;
      if (nsel > 0) p0 = atomicAdd(&cnt[n0], 1);
      if (nsel > 1) p1 = atomicAdd(&cnt[n1], 1);
      if (nsel > 2) p2 = atomicAdd(&cnt[n2], 1);
      __syncthreads();
      if (tid < 32) base[tid] = cnt[tid] > 0 ? atomicAdd(&gcount[bh * 32 + tid], cnt[tid]) : 0;
      __syncthreads();
      if (nsel > 0) list[((long)(bh * 32 + n0)) * 8192 + base[n0] + p0] = (u16)((l << 2) | 0);
      if (nsel > 1) list[((long)(bh * 32 + n1)) * 8192 + base[n1] + p1] = (u16)((l << 2) | 1);
      if (nsel > 2) list[((long)(bh * 32 + n2)) * 8192 + base[n2] + p2] = (u16)((l << 2) | 2);
      __syncthreads();
    }
  }
  {
    const bool part = RGRID > 16;
    if (!part || RBLK >= 16) {
      const int tvb = part ? (RBLK - 16) * 2 + VHALF : VB, tnvb = part ? (RGRID - 16) * 2 : NVB;
    const float* Ktab = (const float*)(ws + OFF_KTAB);
    u16* Wy = (u16*)(ws + OFF_WY);
    for (long idx = (long)tvb * 256 + VT; idx < 32L * 1024 * 128; idx += (long)tnvb * 256) {
      int g = (int)(idx >> 17), n = (int)(idx >> 7) & 1023, k8 = (int)idx & 127, i = n >> 4, h = n & 15, j = k8 >> 1, hp0 = (k8 & 1) * 8;
      if (k8 * 8 >= ((n >> 7) + 1) * 128) continue;
      uint4 o = make_uint4(0, 0, 0, 0);
      if (j <= i) {
        const float4* kp = reinterpret_cast<const float4*>(Ktab + ((g * 64 + (i - j)) * 16 + h) * 16 + hp0);
        float4 a = kp[0], b = kp[1];
        o = make_uint4(pack2bf(a.x, a.y), pack2bf(a.z, a.w), pack2bf(b.x, b.y), pack2bf(b.z, b.w));
      }
      *reinterpret_cast<uint4*>(Wy + ((long)g * 1024 + n) * UGLD + k8 * 8) = o;
    }
    }
  }
}

DI float xor32_max(float v) { const auto r = __builtin_amdgcn_permlane32_swap(__float_as_uint(v), __float_as_uint(v), false, false); return fmaxf(__uint_as_float(r[0]), __uint_as_float(r[1])); }
DI float xor32_sum(float v) { const auto r = __builtin_amdgcn_permlane32_swap(__float_as_uint(v), __float_as_uint(v), false, false); return __uint_as_float(r[0]) + __uint_as_float(r[1]); }
DI int crow(int i, int hh) { return (i & 3) + 8 * (i >> 2) + 4 * hh; }

DI void attn_task(const Params& P, int bh, int n, int t, int lane, const char* Ks, const char* Vs) {
  char* ws = P.ws;
  const u16* Qb = (const u16*)(ws + OFF_QB);
  const int* gcount = (const int*)(ws + OFF_GCOUNT); const u16* list = (const u16*)(ws + OFF_LIST);
  u16* Opart = (u16*)(ws + OFF_OPART); float* Lse = (float*)(ws + OFF_LSE);
  const int b = bh >> 3, h = bh & 7, r = lane & 31, hh = lane >> 5;
  const bool own = t < 8;
  int lq, slot; bool valid = true;
  if (own) { lq = n * 256 + t * 32 + r; slot = 3; }
  else {
    const int cnt = gcount[bh * 32 + n], idx = (t - 8) * 32 + r;
    valid = idx < cnt;
    const int e = list[((long)(bh * 32 + n)) * 8192 + (valid ? idx : 0)];
    lq = e >> 2; slot = e & 3;
  }
  bf16x8 qf[4];
  {
    const u16* qrow = Qb + ((long)(b * 8192 + lq)) * 512 + h * 64 + 8 * hh;
#pragma unroll
    for (int s = 0; s < 4; ++s) qf[s] = *reinterpret_cast<const bf16x8*>(qrow + 16 * s);
  }
  float m_run = -1e30f, l_run = 0.f;
  f32x16 O0, O1;
#pragma unroll
  for (int i = 0; i < 16; ++i) { O0[i] = 0.f; O1[i] = 0.f; }
  const int nkt = own ? (t + 1) : 8;
  for (int kt = 0; kt < nkt; ++kt) {
    const int kbase = n * 256 + kt * 32;
    const int krow = kt * 32 + r;
    f32x16 S;
#pragma unroll
    for (int i = 0; i < 16; ++i) S[i] = 0.f;
#pragma unroll
    for (int s = 0; s < 4; ++s) {
      const bf16x8 kf = *reinterpret_cast<const bf16x8*>(Ks + krow * 128 + (((2 * s + hh) ^ ((krow >> 1) & 7)) * 16));
      S = __builtin_amdgcn_mfma_f32_32x32x16_bf16(kf, qf[s], S, 0, 0, 0);
    }
    const bool diag = own && (kt == t);
    constexpr float SC2 = 0.125f * 1.4426950408889634f;
    float mx = -1e30f;
#pragma unroll
    for (int i = 0; i < 16; ++i) {
      if (diag && (kbase + crow(i, hh) > lq)) S[i] = -1e30f;
      mx = fmaxf(mx, S[i]);
    }
    mx = xor32_max(mx);
    const float m_new = fmaxf(m_run, mx * SC2);
    const float alpha = __builtin_amdgcn_exp2f(m_run - m_new);
    float rs = 0.f;
#pragma unroll
    for (int i = 0; i < 16; ++i) { float pv = __builtin_amdgcn_exp2f(fmaf(S[i], SC2, -m_new)); S[i] = pv; rs += pv; }
    rs = xor32_sum(rs);
    l_run = l_run * alpha + rs; m_run = m_new;
    if (__ballot(alpha != 1.f)) {
#pragma unroll
      for (int i = 0; i < 16; ++i) { O0[i] *= alpha; O1[i] *= alpha; }
    }
#pragma unroll
    for (int s = 0; s < 2; ++s) {
      const uint4 ppk = make_uint4(pack2bf(S[8 * s], S[8 * s + 1]), pack2bf(S[8 * s + 2], S[8 * s + 3]), pack2bf(S[8 * s + 4], S[8 * s + 5]), pack2bf(S[8 * s + 6], S[8 * s + 7]));
      const bf16x8 pf = __builtin_bit_cast(bf16x8, ppk);
#pragma unroll
      for (int dt = 0; dt < 2; ++dt) {
        const char* vp = Vs + (dt * 32 + r) * 528 + (kt * 32 + 16 * s + 4 * hh) * 2;
        const uint2 lo = *reinterpret_cast<const uint2*>(vp), hi = *reinterpret_cast<const uint2*>(vp + 16);
        const uint4 vv = make_uint4(lo.x, lo.y, hi.x, hi.y);
        if (dt == 0) O0 = __builtin_amdgcn_mfma_f32_32x32x16_bf16(__builtin_bit_cast(bf16x8, vv), pf, O0, 0, 0, 0);
        else O1 = __builtin_amdgcn_mfma_f32_32x32x16_bf16(__builtin_bit_cast(bf16x8, vv), pf, O1, 0, 0, 0);
      }
    }
  }
  if (valid) {
    const float inv = 1.f / l_run;
    const long rowid = ((long)(b * 8192 + lq) * 8 + h) * 4 + slot;
    u16* op = Opart + rowid * 64;
#pragma unroll
    for (int gq = 0; gq < 4; ++gq) {
      *reinterpret_cast<uint2*>(op + 8 * gq + 4 * hh) = make_uint2(pack2bf(O0[4 * gq] * inv, O0[4 * gq + 1] * inv), pack2bf(O0[4 * gq + 2] * inv, O0[4 * gq + 3] * inv));
      *reinterpret_cast<uint2*>(op + 32 + 8 * gq + 4 * hh) = make_uint2(pack2bf(O1[4 * gq] * inv, O1[4 * gq + 1] * inv), pack2bf(O1[4 * gq + 2] * inv, O1[4 * gq + 3] * inv));
    }
    if (hh == 0) Lse[rowid] = (m_run + __log2f(l_run)) * 0.6931471805599453f;
  }
}

DI void phase4(const Params& P, char* smem) {
  char* ws = P.ws;
  const u16* UG = (const u16*)(ws + OFF_UG); const u16* Wy = (const u16*)(ws + OFF_WY);
  u16* Yb = (u16*)(ws + OFF_YB);
  TILE_LOOP(tile, 32 * 4 * 8, 8) {
    const int trow = tile >> 3, g = (trow >> 5) * 8 + (tile & 7), brow = (trow & 3) * 128, cidx = (trow >> 2) & 7, bcol = ((trow & 64) ? 7 - cidx : cidx) * 128;
    gemm_tile<true>(UG + ((long)g * 512 + brow) * UGLD, UGLD, Wy + ((long)g * 1024 + bcol) * UGLD, UGLD, 0, (bcol + 128) / 64, 16, 18, smem, [&](int row, int col0, f32x4 v) {
      const int n = bcol + col0, i = n >> 4, h = n & 15, m = brow + row;
      const float4 dsk = *reinterpret_cast<const float4*>(P.dsk + g * 16 + h);
      const uint2 uu = *reinterpret_cast<const uint2*>(UG + ((long)g * 512 + m) * UGLD + n);
      const float y0 = gelu_t(v[0] + dsk.x * __uint_as_float(uu.x << 16)), y1 = gelu_t(v[1] + dsk.y * __uint_as_float(uu.x & 0xffff0000u));
      const float y2 = gelu_t(v[2] + dsk.z * __uint_as_float(uu.y << 16)), y3 = gelu_t(v[3] + dsk.w * __uint_as_float(uu.y & 0xffff0000u));
      *reinterpret_cast<uint2*>(Yb + ((long)m * 64 + i) * 512 + g * 16 + h) = make_uint2(pack2bf(y0, y1), pack2bf(y2, y3));
    });
  }
  const int wid = VT >> 6, lane = VT & 63, tid = VT;
  const int* gcount = (const int*)(ws + OFF_GCOUNT);
  const u16* Kb = (const u16*)(ws + OFF_KB); const u16* Vt = (const u16*)(ws + OFF_VT);
  char* Ks = smem; char* Vs = smem + 32768;
  int* pre = (int*)(smem + 32768 + 33792);
  int* part = pre + 1032;
  __syncthreads();
  {
    if (tid < 32) { int s = 0; for (int k = 0; k < 32; ++k) s += (4 + ((gcount[tid * 32 + k] + 31) >> 5) + 7) >> 3; part[tid + 1] = s; }
    __syncthreads();
    if (tid == 0) { part[0] = 0; for (int k = 1; k <= 32; ++k) part[k] += part[k - 1]; }
    __syncthreads();
    if (tid < 32) { int s = part[tid]; for (int k = 0; k < 32; ++k) { pre[tid * 32 + k] = s; s += (4 + ((gcount[tid * 32 + k] + 31) >> 5) + 7) >> 3; } }
    if (tid == 0) pre[1024] = part[32];
    __syncthreads();
  }
  const int total = pre[1024];
  const int per = (total + 7) >> 3, slot = (RBLK >> 3) * 2 + VHALF, nslot = (RGRID >> 3) * 2;
  for (int k0 = 0; k0 < per; k0 += nslot) {
    const int kk = k0 + slot, it_ = (RBLK & 7) * per + kk;
    const bool act = kk < per && it_ < total;
    const int it = act ? it_ : 0;
    int lo = 0, hi = 1024;
    while (hi - lo > 1) { const int mid = (lo + hi) >> 1; if (pre[mid] <= it) lo = mid; else hi = mid; }
    const int bh = lo >> 5, n = lo & 31, b = bh >> 3, h = bh & 7;
    const int ntask = 4 + ((gcount[lo] + 31) >> 5);
    const int task = (it - pre[lo]) * 8 + wid;
    uint4 kr[8], vr[8];
#pragma unroll
    for (int i = 0; i < 8; ++i) {
      const int q = i * 256 + tid;
      kr[i] = *reinterpret_cast<const uint4*>(Kb + ((long)(b * 8192 + n * 256 + (q >> 3))) * 512 + h * 64 + (q & 7) * 8);
      vr[i] = *reinterpret_cast<const uint4*>(Vt + ((long)(bh * 64 + (q >> 5))) * 8192 + n * 256 + (q & 31) * 8);
    }
#pragma unroll
    for (int i = 0; i < 8; ++i) {
      const int q = i * 256 + tid, row = q >> 3;
      *reinterpret_cast<uint4*>(Ks + row * 128 + (((q & 7) ^ ((row >> 1) & 7)) * 16)) = kr[i];
      *reinterpret_cast<uint4*>(Vs + (q >> 5) * 528 + (q & 31) * 16) = vr[i];
    }
    __syncthreads();
    if (act && task < ntask) {
      if (task < 4) { attn_task(P, bh, n, task, lane, Ks, Vs); attn_task(P, bh, n, 7 - task, lane, Ks, Vs); }
      else attn_task(P, bh, n, task - 4 + 8, lane, Ks, Vs);
    }
    if (act && task + 4 < ntask) attn_task(P, bh, n, task + 4 - 4 + 8, lane, Ks, Vs);
    __syncthreads();
  }
}

DI void phase5(const Params& P, char* smem) {
  char* ws = P.ws;
  const u16* Yb = (const u16*)(ws + OFF_YB); const u16* WgT = (const u16*)(ws + OFF_WGT);
  u16* cat = (u16*)(ws + OFF_CAT);
  TILE_LOOP(tile, 256 * 4, 4) {
    const int brow = (tile >> 2) * 128, bcol = (tile & 3) * 128;
    gemm_tile<true>(Yb + (long)brow * 512, 512, WgT + (long)bcol * 512, 512, 0, 8, 0, 0, smem, [&](int row, int col0, f32x4 v) {
      const long r = brow + row; const int c = bcol + col0;
      const uint2 yy = *reinterpret_cast<const uint2*>(Yb + r * 512 + c);
      const float o0 = __uint_as_float(yy.x << 16) / (1.f + __expf(-v[0])), o1 = __uint_as_float(yy.x & 0xffff0000u) / (1.f + __expf(-v[1]));
      const float o2 = __uint_as_float(yy.y << 16) / (1.f + __expf(-v[2])), o3 = __uint_as_float(yy.y & 0xffff0000u) / (1.f + __expf(-v[3]));
      *reinterpret_cast<uint2*>(cat + r * 1024 + c) = make_uint2(pack2bf(o0, o1), pack2bf(o2, o3));
    });
  }
  const u16* Opart = (const u16*)(ws + OFF_OPART); const float* Lse = (const float*)(ws + OFF_LSE);
  for (long idx = (long)VB * 256 + VT; idx < (long)NTOK * 64; idx += (long)NVB * 256) {
    const int dg = (int)idx & 7, h = (int)(idx >> 3) & 7; const long tok = idx >> 6;
    const int l = (int)(tok & 8191); const int ownb = l >> 8; const int nv = ownb < 3 ? ownb : 3;
    const long base = (tok * 8 + h) * 4;
    float ls[4]; float mx = -3e38f;
#pragma unroll
    for (int s = 0; s < 4; ++s) { const bool ok = (s == 3) || (s < nv); ls[s] = ok ? Lse[base + s] : -3e38f; mx = fmaxf(mx, ls[s]); }
    float acc[8]; float wsum = 0.f;
#pragma unroll
    for (int k = 0; k < 8; ++k) acc[k] = 0.f;
#pragma unroll
    for (int s = 0; s < 4; ++s) {
      const bool ok = (s == 3) || (s < nv);
      if (ok) {
        const float w = __expf(ls[s] - mx); wsum += w;
        uint4 o = *reinterpret_cast<const uint4*>(Opart + (base + s) * 64 + dg * 8);
        acc[0] += w * __uint_as_float(o.x << 16); acc[1] += w * __uint_as_float(o.x & 0xffff0000u);
        acc[2] += w * __uint_as_float(o.y << 16); acc[3] += w * __uint_as_float(o.y & 0xffff0000u);
        acc[4] += w * __uint_as_float(o.z << 16); acc[5] += w * __uint_as_float(o.z & 0xffff0000u);
        acc[6] += w * __uint_as_float(o.w << 16); acc[7] += w * __uint_as_float(o.w & 0xffff0000u);
      }
    }
    const float inv = 1.f / wsum;
    *reinterpret_cast<uint4*>(cat + tok * 1024 + 512 + h * 64 + dg * 8) =
        make_uint4(pack2bf(acc[0] * inv, acc[1] * inv), pack2bf(acc[2] * inv, acc[3] * inv), pack2bf(acc[4] * inv, acc[5] * inv), pack2bf(acc[6] * inv, acc[7] * inv));
  }
}

DI void phase6(const Params& P, char* smem) {
  char* ws = P.ws;
  const u16* cat = (const u16*)(ws + OFF_CAT); const u16* WoT = (const u16*)(ws + OFF_WOT);
  float* Z1 = (float*)(ws + OFF_Z1);
  for (int q = RBLK >> 3; q < 64; q += RGRID >> 3) {
    const int brow = (q * 2 + ((RBLK & 7) >> 2)) * 256, bcol = (RBLK & 3) * 256;
    gemm_tile256(cat + (long)brow * 1024, 1024, WoT + (long)bcol * 1024, 1024, 32, smem, [&](int row, int col0, f32x4 v) {
      const long o = (long)(brow + row) * 1024 + bcol + col0;
      const float4 xs = *reinterpret_cast<const float4*>(P.x + o);
      *reinterpret_cast<float4*>(Z1 + o) = make_float4(ALPHA * xs.x + v[0], ALPHA * xs.y + v[1], ALPHA * xs.z + v[2], ALPHA * xs.w + v[3]);
    });
  }
}

DI void phase7(const Params& P, char* smem) {
  char* ws = P.ws;
  const float* Z1 = (const float*)(ws + OFF_Z1);
  _Float16* h1h = (_Float16*)(ws + OFF_H1H); u16* h1b = (u16*)(ws + OFF_H1B);
  const int wid = VT >> 6, lane = VT & 63;
  for (int row = VB * 4 + wid; row < NTOK; row += NVB * 4) {
    float4 z[4]; float s = 0.f;
#pragma unroll
    for (int k = 0; k < 4; ++k) { z[k] = *reinterpret_cast<const float4*>(Z1 + (long)row * 1024 + k * 256 + lane * 4); s += z[k].x + z[k].y + z[k].z + z[k].w; }
    const float mu = wave_sum(s) * (1.f / 1024.f);
    float q = 0.f;
#pragma unroll
    for (int k = 0; k < 4; ++k) { float a = z[k].x - mu, b = z[k].y - mu, c = z[k].z - mu, d = z[k].w - mu; q += a * a + b * b + c * c + d * d; }
    const float rstd = rsqrtf(wave_sum(q) * (1.f / 1024.f) + 1e-5f);
#pragma unroll
    for (int k = 0; k < 4; ++k) {
      const int c0 = k * 256 + lane * 4;
      const float4 gg = *reinterpret_cast<const float4*>(P.ln1g + c0), bb = *reinterpret_cast<const float4*>(P.ln1b + c0);
      const float y0 = (z[k].x - mu) * rstd * gg.x + bb.x, y1 = (z[k].y - mu) * rstd * gg.y + bb.y, y2 = (z[k].z - mu) * rstd * gg.z + bb.z, y3 = (z[k].w - mu) * rstd * gg.w + bb.w;
      typedef _Float16 h4 __attribute__((ext_vector_type(4)));
      h4 hv; hv[0] = (_Float16)y0; hv[1] = (_Float16)y1; hv[2] = (_Float16)y2; hv[3] = (_Float16)y3;
      *reinterpret_cast<h4*>(h1h + (long)row * 1024 + c0) = hv;
      *reinterpret_cast<uint2*>(h1b + (long)row * 1024 + c0) = make_uint2(pack2bf(y0, y1), pack2bf(y2, y3));
      z[k] = make_float4(y0, y1, y2, y3);
    }
    float am = 0.f;
#pragma unroll
    for (int k = 0; k < 4; ++k) am = fmaxf(am, fmaxf(fmaxf(fabsf(z[k].x), fabsf(z[k].y)), fmaxf(fabsf(z[k].z), fabsf(z[k].w))));
    am = wave_max(am);
    const float xinv = am > 0.f ? 127.f / am : 0.f;
#pragma unroll
    for (int k = 0; k < 4; ++k) {
      const unsigned pk = ((unsigned)((int)rintf(z[k].x * xinv) & 0xff)) | ((unsigned)((int)rintf(z[k].y * xinv) & 0xff) << 8) |
                          ((unsigned)((int)rintf(z[k].z * xinv) & 0xff) << 16) | ((unsigned)((int)rintf(z[k].w * xinv) & 0xff) << 24);
      *reinterpret_cast<unsigned*>(ws + OFF_XQ + (long)row * 1024 + k * 256 + lane * 4) = pk;
    }
    if (lane == 0) reinterpret_cast<float*>(ws + OFF_SX)[row] = am * (1.f / 127.f);
  }
  for (int row = VB * 4 + wid; row < 2 * 16384; row += NVB * 4) {
    const bool isv = row >= 16384; const int e = row & 16383;
    const float* src = (isv ? P.pv : P.pu) + (long)e * 1024 + lane * 16;
    float f[16];
#pragma unroll
    for (int k = 0; k < 4; ++k) { const float4 a = reinterpret_cast<const float4*>(src)[k]; f[4 * k] = a.x; f[4 * k + 1] = a.y; f[4 * k + 2] = a.z; f[4 * k + 3] = a.w; }
    float am = 0.f;
#pragma unroll
    for (int k = 0; k < 16; ++k) am = fmaxf(am, fabsf(f[k]));
    am = wave_max(am);
    const float inv = am > 0.f ? 127.f / am : 0.f;
    unsigned w[4];
#pragma unroll
    for (int k = 0; k < 4; ++k) {
      unsigned pk = 0;
#pragma unroll
      for (int b = 0; b < 4; ++b) { int q = (int)rintf(f[4 * k + b] * inv); q = q > 127 ? 127 : (q < -127 ? -127 : q); pk |= ((unsigned)((isv ? q + 128 : q) & 0xff)) << (8 * b); }
      w[k] = pk;
    }
    *reinterpret_cast<uint4*>(ws + (isv ? OFF_VQ + ((long)(lane >> 3) * 16384 + e) * 128 + (lane & 7) * 16 : OFF_UQ + (long)e * 1024 + lane * 16)) = make_uint4(w[0], w[1], w[2], w[3]);
    if (lane == 0) reinterpret_cast<float*>(ws + (isv ? OFF_VS : OFF_US))[e] = am * (1.f / 127.f);
  }
}

DI void phase8(const Params& P, char* smem) {
  char* ws = P.ws;
  const u16* h1b = (const u16*)(ws + OFF_H1B); const u16* WqT = (const u16*)(ws + OFF_WQT);
  u16* Qp = (u16*)(ws + OFF_QP);
  for (int q = RBLK >> 3; q < 128; q += RGRID >> 3) {
    const int brow = q * 256, bcol = (RBLK & 7) * 256;
    gemm_tile256(h1b + (long)brow * 1024, 1024, WqT + (long)bcol * 1024, 1024, 32, smem, [&](int row, int col0, f32x4 v) {
      *reinterpret_cast<uint2*>(Qp + (long)(brow + row) * 2048 + bcol + col0) = make_uint2(pack2bf(v[0], v[1]), pack2bf(v[2], v[3]));
    });
  }
}

DI void phase9(const Params& P, char* smem) {
  char* ws = P.ws;
  const u16* Qp = (const u16*)(ws + OFF_QP); const u16* SKb = (const u16*)(ws + OFF_SKB);
  _Float16* ST = (_Float16*)(ws + OFF_ST);
  TILE_LOOP(tile, 256 * 16, 16) {
    const int brow = (tile >> 4) * 128, hc = tile & 15;
    gemm_tile<false>(Qp + (long)brow * 2048 + hc * 128, 2048, SKb + (long)hc * 128 * 128, 128, 0, 2, 0, 0, smem, [&](int row0, int col, f32x4 v) {
      typedef _Float16 h4 __attribute__((ext_vector_type(4)));
      h4 hv; hv[0] = (_Float16)v[0]; hv[1] = (_Float16)v[1]; hv[2] = (_Float16)v[2]; hv[3] = (_Float16)v[3];
      *reinterpret_cast<h4*>(ST + ((long)(hc * 128 + col)) * NTOK + brow + row0) = hv;
    });
  }
}

DI unsigned umax_(unsigned a, unsigned b) { return a > b ? a : b; }
DI unsigned umin_(unsigned a, unsigned b) { return a < b ? a : b; }
#define CE(a, b) { const unsigned hi_ = umax_(a, b), lo_ = umin_(a, b); a = hi_; b = lo_; }
#define SORT16(A) CE(A[0],A[1]) CE(A[2],A[3]) CE(A[4],A[5]) CE(A[6],A[7]) CE(A[8],A[9]) CE(A[10],A[11]) CE(A[12],A[13]) CE(A[14],A[15]) CE(A[0],A[2]) CE(A[1],A[3]) CE(A[4],A[6]) CE(A[5],A[7]) CE(A[8],A[10]) CE(A[9],A[11]) CE(A[12],A[14]) CE(A[13],A[15]) CE(A[1],A[2]) CE(A[5],A[6]) CE(A[9],A[10]) CE(A[13],A[14]) CE(A[0],A[4]) CE(A[1],A[5]) CE(A[2],A[6]) CE(A[3],A[7]) CE(A[8],A[12]) CE(A[9],A[13]) CE(A[10],A[14]) CE(A[11],A[15]) CE(A[2],A[4]) CE(A[3],A[5]) CE(A[10],A[12]) CE(A[11],A[13]) CE(A[1],A[2]) CE(A[3],A[4]) CE(A[5],A[6]) CE(A[9],A[10]) CE(A[11],A[12]) CE(A[13],A[14]) CE(A[0],A[8]) CE(A[1],A[9]) CE(A[2],A[10]) CE(A[3],A[11]) CE(A[4],A[12]) CE(A[5],A[13]) CE(A[6],A[14]) CE(A[7],A[15]) CE(A[4],A[8]) CE(A[5],A[9]) CE(A[6],A[10]) CE(A[7],A[11]) CE(A[2],A[4]) CE(A[3],A[5]) CE(A[6],A[8]) CE(A[7],A[9]) CE(A[10],A[12]) CE(A[11],A[13]) CE(A[1],A[2]) CE(A[3],A[4]) CE(A[5],A[6]) CE(A[7],A[8]) CE(A[9],A[10]) CE(A[11],A[12]) CE(A[13],A[14])
#define MERGE16(R,G) R[0]=umax_(R[0],G[15]); R[1]=umax_(R[1],G[14]); R[2]=umax_(R[2],G[13]); R[3]=umax_(R[3],G[12]); R[4]=umax_(R[4],G[11]); R[5]=umax_(R[5],G[10]); R[6]=umax_(R[6],G[9]); R[7]=umax_(R[7],G[8]); R[8]=umax_(R[8],G[7]); R[9]=umax_(R[9],G[6]); R[10]=umax_(R[10],G[5]); R[11]=umax_(R[11],G[4]); R[12]=umax_(R[12],G[3]); R[13]=umax_(R[13],G[2]); R[14]=umax_(R[14],G[1]); R[15]=umax_(R[15],G[0]); CE(R[0],R[8]) CE(R[1],R[9]) CE(R[2],R[10]) CE(R[3],R[11]) CE(R[4],R[12]) CE(R[5],R[13]) CE(R[6],R[14]) CE(R[7],R[15]) CE(R[0],R[4]) CE(R[1],R[5]) CE(R[2],R[6]) CE(R[3],R[7]) CE(R[8],R[12]) CE(R[9],R[13]) CE(R[10],R[14]) CE(R[11],R[15]) CE(R[0],R[2]) CE(R[1],R[3]) CE(R[4],R[6]) CE(R[5],R[7]) CE(R[8],R[10]) CE(R[9],R[11]) CE(R[12],R[14]) CE(R[13],R[15]) CE(R[0],R[1]) CE(R[2],R[3]) CE(R[4],R[5]) CE(R[6],R[7]) CE(R[8],R[9]) CE(R[10],R[11]) CE(R[12],R[13]) CE(R[14],R[15])

DI void topk_half(const _Float16* __restrict__ sp, unsigned (&R)[16]) {
#pragma unroll
  for (int e = 0; e < 16; ++e) R[e] = 0u;
#pragma unroll 1
  for (int gi = 0; gi < 8; ++gi) {
    unsigned Gk[16];
#pragma unroll
    for (int e = 0; e < 16; ++e) {
      const int n = gi * 16 + e;
      const unsigned bits = __builtin_bit_cast(unsigned short, sp[(long)n * NTOK]);
      const unsigned o = (bits & 0x8000u) ? (~bits & 0xffffu) : (bits | 0x8000u);
      Gk[e] = (o << 16) | (unsigned)(127 - n);
    }
    SORT16(Gk)
    MERGE16(R, Gk)
  }
}
DI float key_val16(unsigned k) { const unsigned o = k >> 16; const unsigned short b = (unsigned short)((o & 0x8000u) ? (o & 0x7fffu) : (~o & 0xffffu)); return (float)__builtin_bit_cast(_Float16, b); }
DI unsigned candkey(float s, int pos) { const unsigned b = __float_as_uint(s); const unsigned o = (b >> 31) ? ~b : (b ^ 0x80000000u); return (o & 0xffffff00u) | (unsigned)(255 - pos); }
DI unsigned lut4(const unsigned (&W)[4], int a) { const int j = a >> 2; const unsigned w = j == 0 ? W[0] : (j == 1 ? W[1] : (j == 2 ? W[2] : W[3])); return (w >> ((a & 3) * 8)) & 0xffu; }

DI void phase10(const Params& P, char* smem) {
  char* ws = P.ws;
  const _Float16* ST = (const _Float16*)(ws + OFF_ST);
  int* Eidx = (int*)(ws + OFF_EIDX); float* G = (float*)(ws + OFF_G);
  for (long id = (long)VB * 256 + VT; id < (long)NTOK * 8; id += (long)NVB * 256) {
    const int t = (int)(id & (NTOK - 1)), h = (int)(id >> 15);
    unsigned R1[16], R2[16];
    topk_half(ST + ((long)(h * 2 + 0) * 128) * NTOK + t, R1);
    topk_half(ST + ((long)(h * 2 + 1) * 128) * NTOK + t, R2);
    float v1[16], v2[16]; unsigned W1[4] = {0u, 0u, 0u, 0u}, W2[4] = {0u, 0u, 0u, 0u};
#pragma unroll
    for (int k = 0; k < 16; ++k) {
      v1[k] = key_val16(R1[k]); v2[k] = key_val16(R2[k]);
      W1[k >> 2] |= (127u - (R1[k] & 127u)) << ((k & 3) * 8);
      W2[k >> 2] |= (127u - (R2[k] & 127u)) << ((k & 3) * 8);
    }
    unsigned C0[16], C1[16], C2[16], C3[16];
    C0[0] = candkey(v1[0] + v2[0], 0);
    C0[1] = candkey(v1[0] + v2[1], 1);
    C0[2] = candkey(v1[0] + v2[2], 2);
    C0[3] = candkey(v1[0] + v2[3], 3);
    C0[4] = candkey(v1[0] + v2[4], 4);
    C0[5] = candkey(v1[0] + v2[5], 5);
    C0[6] = candkey(v1[0] + v2[6], 6);
    C0[7] = candkey(v1[0] + v2[7], 7);
    C0[8] = candkey(v1[0] + v2[8], 8);
    C0[9] = candkey(v1[0] + v2[9], 9);
    C0[10] = candkey(v1[0] + v2[10], 10);
    C0[11] = candkey(v1[0] + v2[11], 11);
    C0[12] = candkey(v1[0] + v2[12], 12);
    C0[13] = candkey(v1[0] + v2[13], 13);
    C0[14] = candkey(v1[0] + v2[14], 14);
    C0[15] = candkey(v1[0] + v2[15], 15);
    C1[0] = candkey(v1[1] + v2[0], 16);
    C1[1] = candkey(v1[1] + v2[1], 17);
    C1[2] = candkey(v1[1] + v2[2], 18);
    C1[3] = candkey(v1[1] + v2[3], 19);
    C1[4] = candkey(v1[1] + v2[4], 20);
    C1[5] = candkey(v1[1] + v2[5], 21);
    C1[6] = candkey(v1[1] + v2[6], 22);
    C1[7] = candkey(v1[1] + v2[7], 23);
    C1[8] = candkey(v1[2] + v2[0], 32);
    C1[9] = candkey(v1[2] + v2[1], 33);
    C1[10] = candkey(v1[2] + v2[2], 34);
    C1[11] = candkey(v1[2] + v2[3], 35);
    C1[12] = candkey(v1[2] + v2[4], 36);
    C1[13] = candkey(v1[3] + v2[0], 48);
    C1[14] = candkey(v1[3] + v2[1], 49);
    C1[15] = candkey(v1[3] + v2[2], 50);
    C2[0] = candkey(v1[3] + v2[3], 51);
    C2[1] = candkey(v1[4] + v2[0], 64);
    C2[2] = candkey(v1[4] + v2[1], 65);
    C2[3] = candkey(v1[4] + v2[2], 66);
    C2[4] = candkey(v1[5] + v2[0], 80);
    C2[5] = candkey(v1[5] + v2[1], 81);
    C2[6] = candkey(v1[6] + v2[0], 96);
    C2[7] = candkey(v1[6] + v2[1], 97);
    C2[8] = candkey(v1[7] + v2[0], 112);
    C2[9] = candkey(v1[7] + v2[1], 113);
    C2[10] = candkey(v1[8] + v2[0], 128);
    C2[11] = candkey(v1[9] + v2[0], 144);
    C2[12] = candkey(v1[10] + v2[0], 160);
    C2[13] = candkey(v1[11] + v2[0], 176);
    C2[14] = candkey(v1[12] + v2[0], 192);
    C2[15] = candkey(v1[13] + v2[0], 208);
    C3[0] = candkey(v1[14] + v2[0], 224);
    C3[1] = candkey(v1[15] + v2[0], 240);
    C3[2] = 0u;
    C3[3] = 0u;
    C3[4] = 0u;
    C3[5] = 0u;
    C3[6] = 0u;
    C3[7] = 0u;
    C3[8] = 0u;
    C3[9] = 0u;
    C3[10] = 0u;
    C3[11] = 0u;
    C3[12] = 0u;
    C3[13] = 0u;
    C3[14] = 0u;
    C3[15] = 0u;
    SORT16(C1) SORT16(C2) SORT16(C3)
    MERGE16(C0, C1) MERGE16(C0, C2) MERGE16(C0, C3)
    float e[16]; int te[16]; float sum = 0.f;
    const float tv0 = [&]() { const unsigned o = C0[0] & 0xffffff00u; return __uint_as_float((o >> 31) ? (o ^ 0x80000000u) : ~o); }();
#pragma unroll
    for (int k = 0; k < 16; ++k) {
      const unsigned key = C0[k]; const unsigned o = key & 0xffffff00u;
      const float val = __uint_as_float((o >> 31) ? (o ^ 0x80000000u) : ~o);
      const int pos = 255 - (int)(key & 255u);
      te[k] = (int)(lut4(W1, pos >> 4) * 128u + lut4(W2, pos & 15));
      e[k] = __expf(val - tv0); sum += e[k];
    }
    const float inv = 1.f / sum;
    int4* ep = reinterpret_cast<int4*>(Eidx + ((long)t * 8 + h) * 16);
    float4* gp = reinterpret_cast<float4*>(G + ((long)t * 8 + h) * 16);
#pragma unroll
    for (int k = 0; k < 4; ++k) {
      ep[k] = make_int4(te[4 * k], te[4 * k + 1], te[4 * k + 2], te[4 * k + 3]);
      gp[k] = make_float4(e[4 * k] * inv, e[4 * k + 1] * inv, e[4 * k + 2] * inv, e[4 * k + 3] * inv);
    }
  }
}

DI int dpp_row_sum_i(int v) {
  v += __builtin_amdgcn_update_dpp(0, v, 0xB1, 0xF, 0xF, true);
  v += __builtin_amdgcn_update_dpp(0, v, 0x4E, 0xF, 0xF, true);
  v += __builtin_amdgcn_update_dpp(0, v, 0x141, 0xF, 0xF, true);
  v += __builtin_amdgcn_update_dpp(0, v, 0x140, 0xF, 0xF, true);
  return v;
}
DI int wave_sum_i(int v) { v = dpp_row_sum_i(v); return __builtin_amdgcn_readlane(v, 0) + __builtin_amdgcn_readlane(v, 16) + __builtin_amdgcn_readlane(v, 32) + __builtin_amdgcn_readlane(v, 48); }

DI void phase11a(const Params& P, char* smem_all) {
  char* ws = P.ws;
  const char* Uq = ws + OFF_UQ; const float* Us = (const float*)(ws + OFF_US); const float* Vs = (const float*)(ws + OFF_VS);
  const int* Eidx = (const int*)(ws + OFF_EIDX); const float* G = (const float*)(ws + OFF_G);
  const char* xq = ws + OFF_XQ; const float* sxp = (const float*)(ws + OFF_SX);
  float* W2 = (float*)(ws + OFF_W2); int* E2 = (int*)(ws + OFF_E2);
  const int j = RBLK & 7, lane = RTID & 63, wslot = (RBLK >> 3) * 8 + (RTID >> 6), nw = (RGRID >> 3) * 8;
  const int l16 = lane & 15, rg = lane >> 4;
  uint2* lst = (uint2*)(smem_all + (RTID >> 6) * 1024);
  int nE0 = Eidx[(long)wslot * 128 + lane], nE1 = Eidx[(long)wslot * 128 + 64 + lane];
  float nG0 = G[(long)wslot * 128 + lane], nG1 = G[(long)wslot * 128 + 64 + lane];
  uint4 nx[4];
#pragma unroll
  for (int c = 0; c < 4; ++c) nx[c] = *reinterpret_cast<const uint4*>(xq + (long)wslot * 1024 + (c * 16 + l16) * 16);
  float nsx = sxp[wslot];
  for (int t = wslot; t < NTOK; t += nw) {
    const int E0 = nE0, E1 = nE1; const float G0 = nG0, G1 = nG1, sx = nsx;
    uint4 xr[4];
#pragma unroll
    for (int c = 0; c < 4; ++c) xr[c] = nx[c];
    bool pf = false;
    const int tn = t + nw < NTOK ? t + nw : t;
    if (j == 0) { E2[(long)t * 128 + (lane & 7) * 16 + (lane >> 3)] = E0; E2[(long)t * 128 + (lane & 7) * 16 + 8 + (lane >> 3)] = E1; }
    const bool in0 = (E0 >> 11) == j, in1 = (E1 >> 11) == j;
    const unsigned long long m0 = __ballot(in0), m1 = __ballot(in1);
    const int c0 = __popcll(m0), cnt = c0 + __popcll(m1);
    const int r0 = __builtin_amdgcn_mbcnt_hi((unsigned)(m0 >> 32), __builtin_amdgcn_mbcnt_lo((unsigned)m0, 0u));
    const int r1 = c0 + __builtin_amdgcn_mbcnt_hi((unsigned)(m1 >> 32), __builtin_amdgcn_mbcnt_lo((unsigned)m1, 0u));
    if (in0) lst[r0] = make_uint2((unsigned)E0 | ((unsigned)lane << 14), __float_as_uint(G0));
    if (in1) lst[r1] = make_uint2((unsigned)E1 | ((unsigned)(64 + lane) << 14), __float_as_uint(G1));
    for (int g0 = 0; g0 < cnt; g0 += 24) {
      const int rem = cnt - g0, ng = rem >= 24 ? 6 : (rem + 3) >> 2;
      int el[6], pl[6]; float gl[6];
#pragma unroll
      for (int gi = 0; gi < 6; ++gi) {
        const int idx = g0 + 4 * gi + rg; const bool ok = idx < cnt;
        const uint2 en = lst[ok ? idx : 0];
        el[gi] = ok ? (int)(en.x & 16383u) : 0; pl[gi] = ok ? (int)(en.x >> 14) : -1; gl[gi] = ok ? __uint_as_float(en.y) : 0.f;
      }
      uint4 u[6][4]; float su[6], sv[6];
#pragma unroll
      for (int gi = 0; gi < 6; ++gi) {
        if (gi < ng) {
          const char* rowp = Uq + (long)el[gi] * 1024 + l16 * 16;
#pragma unroll
          for (int c = 0; c < 4; ++c) u[gi][c] = *reinterpret_cast<const uint4*>(rowp + c * 256);
          su[gi] = Us[el[gi]]; sv[gi] = Vs[el[gi]];
        }
      }
      if (!pf) {
        pf = true;
        nE0 = Eidx[(long)tn * 128 + lane]; nE1 = Eidx[(long)tn * 128 + 64 + lane];
        nG0 = G[(long)tn * 128 + lane]; nG1 = G[(long)tn * 128 + 64 + lane];
#pragma unroll
        for (int c = 0; c < 4; ++c) nx[c] = *reinterpret_cast<const uint4*>(xq + (long)tn * 1024 + (c * 16 + l16) * 16);
        nsx = sxp[tn];
      }
#pragma unroll
      for (int gi = 0; gi < 6; ++gi) {
        if (gi < ng) {
          int d = 0;
#pragma unroll
          for (int c = 0; c < 4; ++c) {
            d = __builtin_amdgcn_sdot4((int)u[gi][c].x, (int)xr[c].x, d, false);
            d = __builtin_amdgcn_sdot4((int)u[gi][c].y, (int)xr[c].y, d, false);
            d = __builtin_amdgcn_sdot4((int)u[gi][c].z, (int)xr[c].z, d, false);
            d = __builtin_amdgcn_sdot4((int)u[gi][c].w, (int)xr[c].w, d, false);
          }
          d = dpp_row_sum_i(d);
          const float dot = (float)d * (su[gi] * sx);
          const float w = gl[gi] * gelu_t(dot) * sv[gi];
          const int p = pl[gi];
          if (l16 == 0 && p >= 0) W2[(long)t * 128 + (p & 7) * 16 + (p >> 3)] = w;
        }
      }
    }
    if (!pf) {
      nE0 = Eidx[(long)tn * 128 + lane]; nE1 = Eidx[(long)tn * 128 + 64 + lane];
      nG0 = G[(long)tn * 128 + lane]; nG1 = G[(long)tn * 128 + 64 + lane];
#pragma unroll
      for (int c = 0; c < 4; ++c) nx[c] = *reinterpret_cast<const uint4*>(xq + (long)tn * 1024 + (c * 16 + l16) * 16);
      nsx = sxp[tn];
    }
  }
}

DI float dpp_row_sum_f(float v) {
  v += __int_as_float(__builtin_amdgcn_update_dpp(0, __float_as_int(v), 0xB1, 0xF, 0xF, true));
  v += __int_as_float(__builtin_amdgcn_update_dpp(0, __float_as_int(v), 0x4E, 0xF, 0xF, true));
  v += __int_as_float(__builtin_amdgcn_update_dpp(0, __float_as_int(v), 0x141, 0xF, 0xF, true));
  v += __int_as_float(__builtin_amdgcn_update_dpp(0, __float_as_int(v), 0x140, 0xF, 0xF, true));
  return v;
}
DI void phase11b(const Params& P, char* smem_all) {
  char* ws = P.ws;
  const char* Vq = ws + OFF_VQ;
  const float* W2 = (const float*)(ws + OFF_W2); const int* E2 = (const int*)(ws + OFF_E2);
  _Float16* Zp = (_Float16*)(ws + OFF_ZP);
  const int j = RBLK & 7, lane = RTID & 63, wv = RTID >> 6, wslot = (RBLK >> 3) * 8 + wv, nw = (RGRID >> 3) * 8;
  float* red = (float*)(smem_all + wv * 4096);
  const char* vbase = Vq + (long)j * 16384 * 128 + (lane & 7) * 16;
  const int g8 = lane >> 3;
  int4 en[4]; float4 wn[4];
  auto load_list = [&](int t) {
#pragma unroll
    for (int k = 0; k < 4; ++k) {
      en[k] = *reinterpret_cast<const int4*>(E2 + (long)t * 128 + g8 * 16 + 4 * k);
      wn[k] = *reinterpret_cast<const float4*>(W2 + (long)t * 128 + g8 * 16 + 4 * k);
    }
  };
  auto gather = [&](uint4 (&v)[16], float (&w)[16]) {
#pragma unroll
    for (int k = 0; k < 4; ++k) {
      v[4 * k] = *reinterpret_cast<const uint4*>(vbase + (long)en[k].x * 128); v[4 * k + 1] = *reinterpret_cast<const uint4*>(vbase + (long)en[k].y * 128);
      v[4 * k + 2] = *reinterpret_cast<const uint4*>(vbase + (long)en[k].z * 128); v[4 * k + 3] = *reinterpret_cast<const uint4*>(vbase + (long)en[k].w * 128);
      w[4 * k] = wn[k].x; w[4 * k + 1] = wn[k].y; w[4 * k + 2] = wn[k].z; w[4 * k + 3] = wn[k].w;
    }
  };
  auto reduce_store = [&](const uint4 (&v)[16], const float (&w)[16], int t) {
    typedef float f2 __attribute__((ext_vector_type(2)));
    f2 acc[8]; float wl = 0.f;
#pragma unroll
    for (int k = 0; k < 8; ++k) acc[k] = f2{0.f, 0.f};
#pragma unroll
    for (int r = 0; r < 16; ++r) {
      wl += w[r];
      const f2 w2 = f2{w[r], w[r]};
      const unsigned vw[4] = {v[r].x, v[r].y, v[r].z, v[r].w};
#pragma unroll
      for (int k = 0; k < 4; ++k) {
        acc[2 * k + 0] = __builtin_elementwise_fma(w2, f2{(float)(vw[k] & 0xffu), (float)((vw[k] >> 8) & 0xffu)}, acc[2 * k + 0]);
        acc[2 * k + 1] = __builtin_elementwise_fma(w2, f2{(float)((vw[k] >> 16) & 0xffu), (float)(vw[k] >> 24)}, acc[2 * k + 1]);
      }
    }
    const float rsum = dpp_row_sum_f(wl);
    const float wsum = (__int_as_float(__builtin_amdgcn_readlane(__float_as_int(rsum), 0)) + __int_as_float(__builtin_amdgcn_readlane(__float_as_int(rsum), 16)) +
                        __int_as_float(__builtin_amdgcn_readlane(__float_as_int(rsum), 32)) + __int_as_float(__builtin_amdgcn_readlane(__float_as_int(rsum), 48))) * 0.125f;
#pragma unroll
    for (int k = 0; k < 4; ++k) *reinterpret_cast<float4*>(red + g8 * 128 + (lane & 7) * 16 + 4 * k) = make_float4(acc[2 * k][0], acc[2 * k][1], acc[2 * k + 1][0], acc[2 * k + 1][1]);
    float2 s = make_float2(0.f, 0.f);
#pragma unroll
    for (int g = 0; g < 8; ++g) { const float2 a = *reinterpret_cast<const float2*>(red + g * 128 + 2 * lane); s.x += a.x; s.y += a.y; }
    h2 zo; zo[0] = (_Float16)(s.x - 128.f * wsum); zo[1] = (_Float16)(s.y - 128.f * wsum);
    *reinterpret_cast<h2*>(Zp + (long)t * 1024 + j * 128 + 2 * lane) = zo;
  };
  auto clampt = [&](int t) { return t < NTOK ? t : wslot; };
  uint4 vA[16], vB[16]; float wA[16], wB[16];
  load_list(wslot); gather(vA, wA);
  load_list(clampt(wslot + nw));
  for (int t = wslot; t < NTOK; t += 2 * nw) {
    gather(vB, wB);
    load_list(clampt(t + 2 * nw));
    reduce_store(vA, wA, t);
    gather(vA, wA);
    load_list(clampt(t + 3 * nw));
    if (t + nw < NTOK) reduce_store(vB, wB, t + nw);
  }
}

DI void phase11c(const Params& P) {
  char* ws = P.ws;
  const _Float16* h1h = (const _Float16*)(ws + OFF_H1H); const _Float16* Zp = (const _Float16*)(ws + OFF_ZP);
  const int wid = VT >> 6, lane = VT & 63;
  float4 gg[4], bb[4];
#pragma unroll
  for (int k = 0; k < 4; ++k) { gg[k] = *reinterpret_cast<const float4*>(P.ln2g + lane * 16 + k * 4); bb[k] = *reinterpret_cast<const float4*>(P.ln2b + lane * 16 + k * 4); }
  const int t0 = VB * 4 + wid, tstep = NVB * 4;
  h8 nx0, nx1, na0, na1;
  {
    const int tt = t0 < NTOK ? t0 : 0;
    nx0 = *reinterpret_cast<const h8*>(h1h + (long)tt * 1024 + lane * 16); nx1 = *reinterpret_cast<const h8*>(h1h + (long)tt * 1024 + lane * 16 + 8);
    na0 = *reinterpret_cast<const h8*>(Zp + (long)tt * 1024 + lane * 16); na1 = *reinterpret_cast<const h8*>(Zp + (long)tt * 1024 + lane * 16 + 8);
  }
  for (int t = t0; t < NTOK; t += tstep) {
    const h8 x0 = nx0, x1 = nx1, a0 = na0, a1 = na1;
    {
      const int tn = t + tstep < NTOK ? t + tstep : t;
      nx0 = *reinterpret_cast<const h8*>(h1h + (long)tn * 1024 + lane * 16); nx1 = *reinterpret_cast<const h8*>(h1h + (long)tn * 1024 + lane * 16 + 8);
      na0 = *reinterpret_cast<const h8*>(Zp + (long)tn * 1024 + lane * 16); na1 = *reinterpret_cast<const h8*>(Zp + (long)tn * 1024 + lane * 16 + 8);
    }
    float z[16]; float s = 0.f;
#pragma unroll
    for (int k = 0; k < 8; ++k) { z[k] = (float)a0[k] + ALPHA * (float)x0[k]; z[8 + k] = (float)a1[k] + ALPHA * (float)x1[k]; }
#pragma unroll
    for (int k = 0; k < 16; ++k) s += z[k];
    const float mu = wave_sum(s) * (1.f / 1024.f);
    float q = 0.f;
#pragma unroll
    for (int k = 0; k < 16; ++k) { const float d = z[k] - mu; q += d * d; }
    const float rstd = rsqrtf(wave_sum(q) * (1.f / 1024.f) + 1e-5f);
#pragma unroll
    for (int k = 0; k < 4; ++k) {
      float4 o;
      o.x = (z[4 * k] - mu) * rstd * gg[k].x + bb[k].x; o.y = (z[4 * k + 1] - mu) * rstd * gg[k].y + bb[k].y;
      o.z = (z[4 * k + 2] - mu) * rstd * gg[k].z + bb[k].z; o.w = (z[4 * k + 3] - mu) * rstd * gg[k].w + bb[k].w;
      *reinterpret_cast<float4*>(P.out + (long)t * 1024 + lane * 16 + k * 4) = o;
    }
  }
}

#define XB_TMO      128
#define XB_XCNT(j)  (256  + 64 * (j))
#define XB_XSUB(j)  (1280 + 64 * (j))
#define XB_XGEN(j)  (2304 + 64 * (j))
#define XB_TOP      3328
#define XB_TOPGEN   3392
#define XCD_BAR_WORDS 3456
#define XB_SPIN_CAP (1u << 18)
#define LAS __attribute__((address_space(3)))

DI unsigned xb_ld(unsigned* p)              { return __hip_atomic_load(p, __ATOMIC_RELAXED, __HIP_MEMORY_SCOPE_AGENT); }
DI unsigned xb_add(unsigned* p, unsigned v) { return __hip_atomic_fetch_add(p, v, __ATOMIC_RELAXED, __HIP_MEMORY_SCOPE_AGENT); }
DI unsigned xb_xcc_id() { return (unsigned)__builtin_amdgcn_s_getreg((3 << 11) | 20) & 0xFu; }
#define XB_SPIN(cond, bar) do { unsigned _sp = 0; while (cond) { __builtin_amdgcn_s_sleep(1); \
    if ((++_sp & 255u) == 0u) { if (xb_ld(&(bar)[XB_TMO])) break; if (_sp > XB_SPIN_CAP) { atomicAdd(&(bar)[XB_TMO], 1u); break; } } } } while (0)

struct XcdBarrier {
    unsigned* bar; unsigned x;
    volatile LAS unsigned* st;
};

DI XcdBarrier xcd_barrier_post(unsigned* bar, volatile LAS unsigned* st) {
    XcdBarrier b; b.bar = bar; b.x = xb_xcc_id(); b.st = st;
    if (threadIdx.x == 0) (void)xb_add(&bar[XB_XCNT(b.x)], 1u);
    return b;
}
DI void xcd_barrier_complete(unsigned* bar, unsigned x, unsigned& nloc, unsigned& nx) {
    const unsigned G = gridDim.x * gridDim.y * gridDim.z;
    unsigned sum, cnt, mine, sp = 0u;
    for (;;) {
        sum = 0u; cnt = 0u; mine = 0u;
#pragma unroll
        for (unsigned j = 0; j < 16; ++j) { const unsigned c = xb_ld(&bar[XB_XCNT(j)]); sum += c; cnt += (c > 0u) ? 1u : 0u; mine = (j == x) ? c : mine; }
        if (sum == G) break;
        __builtin_amdgcn_s_sleep(1);
        if ((++sp & 255u) == 0u) { if (xb_ld(&bar[XB_TMO])) break; if (sp > XB_SPIN_CAP) { atomicAdd(&bar[XB_TMO], 1u); break; } }
    }
    nloc = mine > 0u ? mine : 1u; nx = cnt > 0u ? cnt : 1u;
}

DI void xcd_barrier(const XcdBarrier& b) {
    asm volatile("s_waitcnt vmcnt(0)" ::: "memory");
    __syncthreads();
    if (threadIdx.x == 0) {
        unsigned* bar = b.bar;
        __builtin_amdgcn_s_waitcnt(0);
        unsigned nloc = b.st[0], nx = b.st[1];
        if (nloc == 0u) { xcd_barrier_complete(bar, b.x, nloc, nx); b.st[0] = nloc; b.st[1] = nx; }
        const unsigned old = xb_add(&bar[XB_XSUB(b.x)], 1u);
        const unsigned gen = old / nloc;
        if (old + 1u == (gen + 1u) * nloc) {
            __builtin_amdgcn_fence(__ATOMIC_RELEASE, "agent");
            asm volatile("s_waitcnt vmcnt(0)" ::: "memory");
            const unsigned og = xb_add(&bar[XB_TOP], 1u);
            const unsigned tg = og / nx;
            if (og + 1u == (tg + 1u) * nx) xb_add(&bar[XB_TOPGEN], 1u);
            else XB_SPIN(xb_ld(&bar[XB_TOPGEN]) == tg, bar);
            __builtin_amdgcn_fence(__ATOMIC_ACQUIRE, "agent");
            xb_add(&bar[XB_XGEN(b.x)], 1u);
            asm volatile("s_waitcnt vmcnt(0)" ::: "memory");
        } else {
            XB_SPIN(xb_ld(&bar[XB_XGEN(b.x)]) == gen, bar);
            __builtin_amdgcn_fence(__ATOMIC_ACQUIRE, "agent");
            asm volatile("s_waitcnt vmcnt(0)" ::: "memory");
        }
    }
    __syncthreads();
}


__global__ void __launch_bounds__(512, 1) k_mega(Params P) {
  extern __shared__ __attribute__((aligned(16))) char smem_all[];
  char* smem = smem_all + VHALF * VLDS;
  cg::grid_group grid = cg::this_grid();
  volatile LAS unsigned* xb_st = (volatile LAS unsigned*)(smem_all + 2 * VLDS);
  if (RTID == 0) { xb_st[0] = 0u; xb_st[1] = 0u; xb_st[2] = 0u; xb_st[3] = 0u; }
  __syncthreads();
  const XcdBarrier xb = xcd_barrier_post((unsigned*)(P.ws + OFF_BAR), xb_st);
  if (P.out == nullptr) grid.sync();
  phase0(P, smem); xcd_barrier(xb);
  if (PROBE_DUP == 0) { grid.sync(); phase0(P, smem); grid.sync(); }
  phase1(P, smem_all); xcd_barrier(xb);
  if (PROBE_DUP == 1) { grid.sync(); phase1(P, smem_all); grid.sync(); }
  phase2(P, smem); xcd_barrier(xb);
  if (PROBE_DUP == 2) { grid.sync(); phase2(P, smem); grid.sync(); }
  phase3(P, smem); xcd_barrier(xb);
  if (PROBE_DUP == 3) { grid.sync(); phase3(P, smem); grid.sync(); }
  phase4(P, smem); xcd_barrier(xb);
  if (PROBE_DUP == 4) { grid.sync(); phase4(P, smem); grid.sync(); }
  phase5(P, smem); xcd_barrier(xb);
  if (PROBE_DUP == 5) { grid.sync(); phase5(P, smem); grid.sync(); }
  phase6(P, smem_all); xcd_barrier(xb);
  if (PROBE_DUP == 6) { grid.sync(); phase6(P, smem_all); grid.sync(); }
  phase7(P, smem); xcd_barrier(xb);
  if (PROBE_DUP == 7) { grid.sync(); phase7(P, smem); grid.sync(); }
  phase8(P, smem_all); xcd_barrier(xb);
  if (PROBE_DUP == 8) { grid.sync(); phase8(P, smem_all); grid.sync(); }
  phase9(P, smem); xcd_barrier(xb);
  if (PROBE_DUP == 9) { grid.sync(); phase9(P, smem); grid.sync(); }
  phase10(P, smem); xcd_barrier(xb);
  if (PROBE_DUP == 10) { grid.sync(); phase10(P, smem); grid.sync(); }
  phase11a(P, smem_all); xcd_barrier(xb);
  if (PROBE_DUP == 111) { phase11a(P, smem_all); grid.sync(); }
  phase11b(P, smem_all); xcd_barrier(xb);
  if (PROBE_DUP == 112) { phase11b(P, smem_all); grid.sync(); }
  phase11c(P);
  if (PROBE_DUP == 113) { grid.sync(); phase11c(P); }
}

extern "C" void kernel_launch(void* const* d_in, const int* in_sizes, int n_in, void* d_out, int out_size, void* d_ws, size_t ws_size, hipStream_t stream) {
  if (ws_size < WS_NEED) { fprintf(stderr, "workspace too small: %zu\n", ws_size); return; }
  Params P{};
  P.x = (const float*)d_in[0]; P.w_in = (const float*)d_in[1]; P.a_re = (const float*)d_in[2]; P.a_im = (const float*)d_in[3];
  P.log_dt = (const float*)d_in[4]; P.b_re = (const float*)d_in[5]; P.b_im = (const float*)d_in[6]; P.c_re = (const float*)d_in[7];
  P.c_im = (const float*)d_in[8]; P.dsk = (const float*)d_in[9]; P.w_glu = (const float*)d_in[10]; P.w_out = (const float*)d_in[11];
  P.ln1g = (const float*)d_in[12]; P.ln1b = (const float*)d_in[13]; P.w_q = (const float*)d_in[14]; P.subk = (const float*)d_in[15];
  P.pu = (const float*)d_in[16]; P.pv = (const float*)d_in[17]; P.ln2g = (const float*)d_in[18]; P.ln2b = (const float*)d_in[19];
  P.out = (float*)d_out; P.ws = (char*)d_ws;
  static int grid_blocks = 0;
  if (!grid_blocks) {
    int dev = 0, cus = 0, per_cu = 0;
    hipGetDevice(&dev);
    hipDeviceGetAttribute(&cus, hipDeviceAttributeMultiprocessorCount, dev);
    hipFuncSetAttribute((const void*)k_mega, hipFuncAttributeMaxDynamicSharedMemorySize, LDS_BYTES);
    hipOccupancyMaxActiveBlocksPerMultiprocessor(&per_cu, k_mega, 512, LDS_BYTES);
    if (per_cu > 1) per_cu = 1;
    grid_blocks = (cus * per_cu) & ~7;
  }
  hipMemsetAsync((char*)d_ws + OFF_BAR, 0, XCD_BAR_WORDS * sizeof(unsigned), stream);
  void* args[] = {&P};
  hipError_t e = hipLaunchCooperativeKernel((void*)k_mega, dim3(grid_blocks), dim3(512), args, LDS_BYTES, stream);
  if (e != hipSuccess) fprintf(stderr, "cooperative launch failed: %s (grid %d)\n", hipGetErrorString(e), grid_blocks);
}
```

```cpp
#include <hip/hip_runtime.h>
#include <hip/hip_cooperative_groups.h>
#include <cstdio>
#include <cstdint>
namespace cg = cooperative_groups;

#ifndef PROBE_DUP
#define PROBE_DUP -1
#endif
#define DI __device__ __forceinline__
#define RBLK ((int)blockIdx.x)
#define RGRID ((int)gridDim.x)
#define RTID ((int)threadIdx.x)
#define VHALF (RTID >> 8)
#define VT (RTID & 255)
#define VB (RBLK * 2 + VHALF)
#define NVB (RGRID * 2)
constexpr int VLDS = 70912;

typedef unsigned short u16;
using bf16x8 = __attribute__((ext_vector_type(8))) short;
using f32x4  = __attribute__((ext_vector_type(4))) float;
using f32x16 = __attribute__((ext_vector_type(16))) float;
typedef _Float16 h2 __attribute__((ext_vector_type(2)));
typedef _Float16 h8 __attribute__((ext_vector_type(8)));

constexpr int NTOK = 32768, DM = 1024, SEQ = 8192;
constexpr float ALPHA = 1.189207115002721f;
constexpr size_t MB = 1u << 20;
constexpr size_t OFF_QB = 0, OFF_KB = 32 * MB, OFF_UH = 0, OFF_VH = 32 * MB;
constexpr size_t OFF_UQ = 0, OFF_VQ = 16 * MB, OFF_US = 32 * MB, OFF_VS = 33 * MB;
constexpr size_t OFF_XQ = 400 * MB, OFF_SX = 432 * MB, OFF_W2 = 434 * MB, OFF_E2 = 450 * MB, OFF_ZP = 160 * MB;
constexpr size_t OFF_XB = 64 * MB, OFF_YB = 64 * MB, OFF_H1H = 64 * MB;
constexpr size_t OFF_OPART = 128 * MB, OFF_LSE = 256 * MB, OFF_Z1 = 128 * MB, OFF_QP = 128 * MB, OFF_EIDX = 128 * MB, OFF_G = 144 * MB;
constexpr size_t OFF_WY = 260 * MB, OFF_WST = 332 * MB, OFF_SLOC = 340 * MB, OFF_LIST = 348 * MB;
constexpr size_t OFF_H1B = 256 * MB, OFF_ST = 256 * MB;
constexpr size_t OFF_WINT = 384 * MB, OFF_WQT = 388 * MB, OFF_WOT = 392 * MB, OFF_WGT = 394 * MB, OFF_SKB = 394 * MB + 512 * 1024;
constexpr size_t OFF_KTAB = 395 * MB, OFF_KMEAN = 397 * MB, OFF_GCOUNT = 397 * MB + 256 * 1024;
constexpr size_t OFF_VT = 400 * MB, OFF_CAT = 400 * MB, OFF_UG = 464 * MB;
constexpr size_t WS_NEED = 500 * MB;
constexpr size_t OFF_BAR = 398 * MB;
constexpr int UGLD = 1152;
constexpr int LDS_BYTES = 2 * 70912 + 16;

struct Params {
  const float *x, *w_in, *a_re, *a_im, *log_dt, *b_re, *b_im, *c_re, *c_im, *dsk, *w_glu, *w_out, *ln1g, *ln1b, *w_q, *subk, *pu, *pv, *ln2g, *ln2b;
  float* out;
  char* ws;
};

typedef __bf16 bf2_t __attribute__((ext_vector_type(2)));
typedef float f2_t __attribute__((ext_vector_type(2)));
DI unsigned pack2bf(float a, float b) { const f2_t v = {a, b}; return __builtin_bit_cast(unsigned, __builtin_convertvector(v, bf2_t)); }
DI u16 f2bf(float x) { return (u16)(pack2bf(x, 0.f) & 0xffffu); }
DI float bf2f(u16 b) { return __uint_as_float(((unsigned)b) << 16); }
DI float gelu_t(float x) { float u = 0.7978845608028654f * (x + 0.044715f * x * x * x); float e = __expf(2.f * u); float t = 1.f - 2.f / (1.f + e); return 0.5f * x * (1.f + t); }
DI float2 cmul(float2 a, float2 b) { return make_float2(a.x * b.x - a.y * b.y, a.x * b.y + a.y * b.x); }
DI float2 cexpf2(float re, float im) { float e = expf(re); float s, c; sincosf(im, &s, &c); return make_float2(e * c, e * s); }
DI float dpp_row_sum_f0(float v) {
  v += __int_as_float(__builtin_amdgcn_update_dpp(0, __float_as_int(v), 0xB1, 0xF, 0xF, true));
  v += __int_as_float(__builtin_amdgcn_update_dpp(0, __float_as_int(v), 0x4E, 0xF, 0xF, true));
  v += __int_as_float(__builtin_amdgcn_update_dpp(0, __float_as_int(v), 0x141, 0xF, 0xF, true));
  v += __int_as_float(__builtin_amdgcn_update_dpp(0, __float_as_int(v), 0x140, 0xF, 0xF, true));
  return v;
}
DI float rl_f(float v, int l) { return __int_as_float(__builtin_amdgcn_readlane(__float_as_int(v), l)); }
DI float wave_sum(float v) { v = dpp_row_sum_f0(v); return (rl_f(v, 0) + rl_f(v, 16)) + (rl_f(v, 32) + rl_f(v, 48)); }
DI float wave_max(float v) {
  v = fmaxf(v, __int_as_float(__builtin_amdgcn_update_dpp(0, __float_as_int(v), 0xB1, 0xF, 0xF, true)));
  v = fmaxf(v, __int_as_float(__builtin_amdgcn_update_dpp(0, __float_as_int(v), 0x4E, 0xF, 0xF, true)));
  v = fmaxf(v, __int_as_float(__builtin_amdgcn_update_dpp(0, __float_as_int(v), 0x141, 0xF, 0xF, true)));
  v = fmaxf(v, __int_as_float(__builtin_amdgcn_update_dpp(0, __float_as_int(v), 0x140, 0xF, 0xF, true)));
  return fmaxf(fmaxf(rl_f(v, 0), rl_f(v, 16)), fmaxf(rl_f(v, 32), rl_f(v, 48)));
}

template <bool SWAP, class Epi>
DI void gemm_tile(const u16* __restrict__ Ag, long lda, const u16* __restrict__ Bg, long ldb, int ka0, int ka1, int kb0, int kb1, char* shm, Epi&& epi) {
  const int tid = VT, wid = tid >> 6, lane = tid & 63, wr = wid >> 1, wc = wid & 1, fr = lane & 15, fq = lane >> 4;
  const int na = ka1 - ka0, nk = na + (kb1 - kb0);
  f32x4 acc[4][4];
#pragma unroll
  for (int m = 0; m < 4; ++m)
#pragma unroll
    for (int n = 0; n < 4; ++n) acc[m][n] = f32x4{0.f, 0.f, 0.f, 0.f};
  auto stage = [&](int buf, int kt) {
    char* SA = shm + buf * 32768; char* SB = SA + 16384;
#pragma unroll
    for (int i = 0; i < 4; ++i) {
      const int q = i * 256 + tid, r = q >> 3, c16 = (q & 7) ^ ((r >> 1) & 7);
      __builtin_amdgcn_global_load_lds((const unsigned*)(Ag + (long)r * lda + kt * 64 + c16 * 8), (__attribute__((address_space(3))) unsigned*)(SA + q * 16), 16, 0, 0);
      __builtin_amdgcn_global_load_lds((const unsigned*)(Bg + (long)r * ldb + kt * 64 + c16 * 8), (__attribute__((address_space(3))) unsigned*)(SB + q * 16), 16, 0, 0);
    }
  };
  stage(0, ka0 < ka1 ? ka0 : kb0);
  for (int i = 0; i < nk; ++i) {
    asm volatile("s_waitcnt vmcnt(0)" ::: "memory");
    __syncthreads();
    if (i + 1 < nk) { const int j = i + 1; stage(j & 1, j < na ? ka0 + j : kb0 + (j - na)); }
    const char* SA = shm + (i & 1) * 32768; const char* SB = SA + 16384;
#pragma unroll
    for (int ks = 0; ks < 2; ++ks) {
      bf16x8 At[4], Bt[4];
#pragma unroll
      for (int m = 0; m < 4; ++m) {
        const int ra = wr * 64 + m * 16 + fr, rb = wc * 64 + m * 16 + fr;
        At[m] = *reinterpret_cast<const bf16x8*>(SA + ra * 128 + (((ks * 4 + fq) ^ ((ra >> 1) & 7)) * 16));
        Bt[m] = *reinterpret_cast<const bf16x8*>(SB + rb * 128 + (((ks * 4 + fq) ^ ((rb >> 1) & 7)) * 16));
      }
#pragma unroll
      for (int m = 0; m < 4; ++m)
#pragma unroll
        for (int n = 0; n < 4; ++n) acc[m][n] = SWAP ? __builtin_amdgcn_mfma_f32_16x16x32_bf16(Bt[n], At[m], acc[m][n], 0, 0, 0) : __builtin_amdgcn_mfma_f32_16x16x32_bf16(At[m], Bt[n], acc[m][n], 0, 0, 0);
    }
  }
  __syncthreads();
#pragma unroll
  for (int m = 0; m < 4; ++m)
#pragma unroll
    for (int n = 0; n < 4; ++n) { if (SWAP) epi(wr * 64 + m * 16 + fr, wc * 64 + n * 16 + fq * 4, acc[m][n]); else epi(wr * 64 + m * 16 + fq * 4, wc * 64 + n * 16 + fr, acc[m][n]); }
}

template <class Epi>
DI void gemm_tile256(const u16* __restrict__ Ag, long lda, const u16* __restrict__ Bg, long ldb, int nk, char* shm, Epi&& epi) {
  const int tid = RTID, wid = tid >> 6, lane = tid & 63, wr = wid >> 2, wc = wid & 3, fr = lane & 15, fq = lane >> 4;
  f32x4 acc[8][4];
#pragma unroll
  for (int m = 0; m < 8; ++m)
#pragma unroll
    for (int n = 0; n < 4; ++n) acc[m][n] = f32x4{0.f, 0.f, 0.f, 0.f};
  const int q0 = tid, q1 = 512 + tid;
  const int r0 = q0 >> 2, r1 = q1 >> 2, c0 = (q0 & 3) ^ ((r0 >> 2) & 3), c1 = (q1 & 3) ^ ((r1 >> 2) & 3);
  const u16* a0 = Ag + (long)r0 * lda + c0 * 8; const u16* a1 = Ag + (long)r1 * lda + c1 * 8;
  const u16* b0 = Bg + (long)r0 * ldb + c0 * 8; const u16* b1 = Bg + (long)r1 * ldb + c1 * 8;
  auto stage = [&](int j) {
    char* SA = shm + (j & 3) * 32768; char* SB = SA + 16384;
    __builtin_amdgcn_global_load_lds((const unsigned*)(a0 + j * 32), (__attribute__((address_space(3))) unsigned*)(SA + q0 * 16), 16, 0, 0);
    __builtin_amdgcn_global_load_lds((const unsigned*)(a1 + j * 32), (__attribute__((address_space(3))) unsigned*)(SA + q1 * 16), 16, 0, 0);
    __builtin_amdgcn_global_load_lds((const unsigned*)(b0 + j * 32), (__attribute__((address_space(3))) unsigned*)(SB + q0 * 16), 16, 0, 0);
    __builtin_amdgcn_global_load_lds((const unsigned*)(b1 + j * 32), (__attribute__((address_space(3))) unsigned*)(SB + q1 * 16), 16, 0, 0);
  };
  __syncthreads();
  stage(0);
  if (nk > 1) stage(1);
  if (nk > 2) stage(2);
  for (int i = 0; i < nk; ++i) {
    if (i + 2 < nk) asm volatile("s_waitcnt vmcnt(8)" ::: "memory");
    else if (i + 1 < nk) asm volatile("s_waitcnt vmcnt(4)" ::: "memory");
    else asm volatile("s_waitcnt vmcnt(0)" ::: "memory");
    __builtin_amdgcn_s_barrier();
    __builtin_amdgcn_sched_barrier(0);
    const char* SA = shm + (i & 3) * 32768; const char* SB = SA + 16384;
    bf16x8 At[8], Bt[4];
#pragma unroll
    for (int n = 0; n < 4; ++n) { const int rb = wc * 64 + n * 16 + fr; Bt[n] = *reinterpret_cast<const bf16x8*>(SB + rb * 64 + ((fq ^ ((rb >> 2) & 3)) * 16)); }
#pragma unroll
    for (int m = 0; m < 8; ++m) { const int ra = wr * 128 + m * 16 + fr; At[m] = *reinterpret_cast<const bf16x8*>(SA + ra * 64 + ((fq ^ ((ra >> 2) & 3)) * 16)); }
    if (i + 3 < nk) stage(i + 3);
#pragma unroll
    for (int m = 0; m < 8; ++m)
#pragma unroll
      for (int n = 0; n < 4; ++n) acc[m][n] = __builtin_amdgcn_mfma_f32_16x16x32_bf16(Bt[n], At[m], acc[m][n], 0, 0, 0);
  }
  __syncthreads();
#pragma unroll
  for (int m = 0; m < 8; ++m)
#pragma unroll
    for (int n = 0; n < 4; ++n) epi(wr * 128 + m * 16 + fr, wc * 64 + n * 16 + fq * 4, acc[m][n]);
}

DI int xcd_tile(int q, int x, int C) { if (C >= 8) { const int cpx = C >> 3; return (q / cpx) * C + x * cpx + q % cpx; } const int rpx = 8 / C; return (q * rpx + x / C) * C + (x % C); }
#define TILE_LOOP(tile, N, C)                                                                                          \
  for (int q0_ = (RBLK >> 3) * 2, tile = 0;                                                                            \
       q0_ < (N) / 8 && ((tile = xcd_tile((q0_ + VHALF < (N) / 8 ? q0_ + VHALF : q0_), RBLK & 7, (C))), true);          \
       q0_ += (RGRID >> 3) * 2)

DI void transpose_bf16(const float* __restrict__ src, int K, int N, u16* __restrict__ dst, int vb, int nvb) {
  const long total = (long)(K / 8) * N;
  for (long idx = (long)vb * 256 + VT; idx < total; idx += (long)nvb * 256) {
    int n = (int)(idx % N), k8 = (int)(idx / N);
    unsigned w[4];
#pragma unroll
    for (int j = 0; j < 4; ++j) w[j] = pack2bf(src[(long)(k8 * 8 + 2 * j) * N + n], src[(long)(k8 * 8 + 2 * j + 1) * N + n]);
    *reinterpret_cast<uint4*>(dst + (long)n * K + k8 * 8) = make_uint4(w[0], w[1], w[2], w[3]);
  }
}
DI void cvt_bf16(const float* __restrict__ src, long n, u16* __restrict__ dst, int vb, int nvb) {
  for (long idx = (long)vb * 256 + VT; idx < n / 8; idx += (long)nvb * 256) {
    float4 a = reinterpret_cast<const float4*>(src)[idx * 2], b = reinterpret_cast<const float4*>(src)[idx * 2 + 1];
    reinterpret_cast<uint4*>(dst)[idx] = make_uint4(pack2bf(a.x, a.y), pack2bf(a.z, a.w), pack2bf(b.x, b.y), pack2bf(b.z, b.w));
  }
}
DI void cvt_f16(const float* __restrict__ src, long n, _Float16* __restrict__ dst) {
  for (long idx = (long)VB * 256 + VT; idx < n / 8; idx += (long)NVB * 256) {
    float4 a = reinterpret_cast<const float4*>(src)[idx * 2], b = reinterpret_cast<const float4*>(src)[idx * 2 + 1];
    h8 o; o[0] = (_Float16)a.x; o[1] = (_Float16)a.y; o[2] = (_Float16)a.z; o[3] = (_Float16)a.w; o[4] = (_Float16)b.x; o[5] = (_Float16)b.y; o[6] = (_Float16)b.z; o[7] = (_Float16)b.w;
    reinterpret_cast<h8*>(dst)[idx] = o;
  }
}
DI float2 ssm_f(const Params& P, int g, int p, float dt) {
  float ar = P.a_re[g * 64 + p], ai = P.a_im[g * 64 + p];
  float2 lb = cexpf2(ar * dt, ai * dt);
  float nr = lb.x - 1.f, ni = lb.y, den = ar * ar + ai * ai;
  return make_float2((nr * ar + ni * ai) / den, (ni * ar - nr * ai) / den);
}

DI void phase0(const Params& P, char* smem) {
  char* ws = P.ws;
  cvt_bf16(P.x, (long)NTOK * DM, (u16*)(ws + OFF_XB), VB, NVB);
  transpose_bf16(P.w_in, 1024, 2048, (u16*)(ws + OFF_WINT), VB, NVB);
  const long gtid = (long)VB * 256 + VT, gstride = (long)NVB * 256;
  {
    u16* Wst = (u16*)(ws + OFF_WST);
    for (long idx = gtid; idx < 32L * 64 * 64; idx += gstride) {
      const int g = (int)(idx >> 12), p = (int)(idx >> 6) & 63, j = (int)idx & 63;
      const float dt = expf(P.log_dt[g]);
      const float ar = P.a_re[g * 64 + p], ai = P.a_im[g * 64 + p];
      const float d = (float)(63 - j);
      const float2 E = cmul(cexpf2(ar * dt * d, ai * dt * d), ssm_f(P, g, p, dt));
      unsigned wr_[8], wi_[8];
#pragma unroll
      for (int q = 0; q < 8; ++q) {
        const float2 v0 = cmul(E, make_float2(P.b_re[(g * 64 + p) * 16 + 2 * q], P.b_im[(g * 64 + p) * 16 + 2 * q]));
        const float2 v1 = cmul(E, make_float2(P.b_re[(g * 64 + p) * 16 + 2 * q + 1], P.b_im[(g * 64 + p) * 16 + 2 * q + 1]));
        wr_[q] = pack2bf(v0.x, v1.x); wi_[q] = pack2bf(v0.y, v1.y);
      }
      uint4* dr = reinterpret_cast<uint4*>(Wst + ((long)g * 128 + 2 * p) * 1024 + j * 16);
      uint4* di = reinterpret_cast<uint4*>(Wst + ((long)g * 128 + 2 * p + 1) * 1024 + j * 16);
      dr[0] = make_uint4(wr_[0], wr_[1], wr_[2], wr_[3]); dr[1] = make_uint4(wr_[4], wr_[5], wr_[6], wr_[7]);
      di[0] = make_uint4(wi_[0], wi_[1], wi_[2], wi_[3]); di[1] = make_uint4(wi_[4], wi_[5], wi_[6], wi_[7]);
    }
  }
  {
    float* Ktab = (float*)(ws + OFF_KTAB);
    float2* Es = (float2*)smem;
    for (int item0 = RBLK * 2; item0 < 32 * 64; item0 += RGRID * 2) {
      const int item = item0 + VHALF;
      int g = item >> 6, d = item & 63, tid = VT;
      if (tid < 64) {
        float dt = expf(P.log_dt[g]);
        float ar = P.a_re[g * 64 + tid], ai = P.a_im[g * 64 + tid];
        Es[tid] = cmul(cexpf2(ar * dt * (float)d, ai * dt * (float)d), ssm_f(P, g, tid, dt));
      }
      __syncthreads();
      int h = tid >> 4, hp = tid & 15;
      float s = 0.f;
      for (int p = 0; p < 64; ++p) {
        float2 T = cmul(Es[p], make_float2(P.b_re[(g * 64 + p) * 16 + hp], P.b_im[(g * 64 + p) * 16 + hp]));
        s += P.c_re[(g * 16 + h) * 64 + p] * T.x - P.c_im[(g * 16 + h) * 64 + p] * T.y;
      }
      Ktab[((g * 64 + d) * 16 + h) * 16 + hp] = s;
      __syncthreads();
    }
  }
  {
    int* gcount = (int*)(ws + OFF_GCOUNT);
    for (long idx = gtid; idx < 1024; idx += gstride) gcount[idx] = 0;
  }
}

DI void phase1(const Params& P, char* smem) {
  char* ws = P.ws;
  const u16* xb = (const u16*)(ws + OFF_XB);
  const u16* WinT = (const u16*)(ws + OFF_WINT);
  u16* UG = (u16*)(ws + OFF_UG); u16* Qb = (u16*)(ws + OFF_QB); u16* Kb = (u16*)(ws + OFF_KB); u16* Vt = (u16*)(ws + OFF_VT);
  for (int q = RBLK >> 3; q < 128; q += RGRID >> 3) {
    const int brow = q * 256, bcol = (RBLK & 7) * 256;
    gemm_tile256(xb + (long)brow * 1024, 1024, WinT + (long)bcol * 1024, 1024, 32, smem, [&](int row, int col0, f32x4 v) {
      const int r = brow + row, c = bcol + col0;
      const uint2 pk = make_uint2(pack2bf(v[0], v[1]), pack2bf(v[2], v[3]));
      if (bcol < 512) {
        const int g = c >> 4, hp = c & 15, m = r >> 6, j = r & 63;
        *reinterpret_cast<uint2*>(UG + ((long)g * 512 + m) * UGLD + j * 16 + hp) = pk;
      } else if (bcol < 1024) {
        *reinterpret_cast<uint2*>(Qb + (long)r * 512 + (c - 512)) = pk;
      } else if (bcol < 1536) {
        *reinterpret_cast<uint2*>(Kb + (long)r * 512 + (c - 1024)) = pk;
      } else {
        const int hd = c - 1536, b = r >> 13, l = r & 8191;
#pragma unroll
        for (int j = 0; j < 4; ++j) Vt[((long)(b * 512 + hd + j)) * 8192 + l] = f2bf(v[j]);
      }
    });
  }
}

DI void phase2(const Params& P, char* smem) {
  char* ws = P.ws;
  const u16* UG = (const u16*)(ws + OFF_UG); const u16* Wst = (const u16*)(ws + OFF_WST);
  float* Sloc = (float*)(ws + OFF_SLOC);
  for (int tile0 = RBLK * 2; tile0 < 32 * 4; tile0 += RGRID * 2) {
    const int tile = tile0 + VHALF;
    const int g = tile >> 2, brow = (tile & 3) * 128;
    gemm_tile<true>(UG + ((long)g * 512 + brow) * UGLD, UGLD, Wst + (long)g * 128 * 1024, 1024, 0, 16, 0, 0, smem, [&](int row, int col0, f32x4 v) {
      *reinterpret_cast<float4*>(Sloc + ((long)g * 512 + brow + row) * 128 + col0) = make_float4(v[0], v[1], v[2], v[3]);
    });
  }
  const u16* Kb = (const u16*)(ws + OFF_KB);
  float* kmean = (float*)(ws + OFF_KMEAN);
  float* red = (float*)smem;
  const bool part2 = RGRID > 64;
  if (part2 && RBLK < 64) return;
  for (int item0 = (part2 ? RBLK - 64 : RBLK) * 2; item0 < 1024; item0 += (part2 ? RGRID - 64 : RGRID) * 2) {
    const int item = item0 + VHALF;
    const int bh = item >> 5, n = item & 31, b = bh >> 3, h = bh & 7, tid = VT, d = tid & 63, part = tid >> 6;
    float s = 0.f;
    for (int kk = 0; kk < 64; ++kk) s += bf2f(Kb[((long)(b * 8192 + n * 256 + part * 64 + kk)) * 512 + h * 64 + d]);
    red[tid] = s;
    __syncthreads();
    if (tid < 64) kmean[(bh * 32 + n) * 64 + tid] = (red[tid] + red[tid + 64] + red[tid + 128] + red[tid + 192]) * (1.f / 256.f);
    __syncthreads();
  }
  {
    const bool part = RGRID > 64;
    if (!part || RBLK >= 64) {
      const int vb = part ? (RBLK - 64) * 2 + VHALF : VB, nvb = part ? (RGRID - 64) * 2 : NVB;
      transpose_bf16(P.w_glu, 512, 512, (u16*)(ws + OFF_WGT), vb, nvb);
      transpose_bf16(P.w_out, 1024, 1024, (u16*)(ws + OFF_WOT), vb, nvb);
      transpose_bf16(P.w_q, 1024, 2048, (u16*)(ws + OFF_WQT), vb, nvb);
      cvt_bf16(P.subk, 8 * 2 * 128 * 128, (u16*)(ws + OFF_SKB), vb, nvb);
  {
    u16* Wy = (u16*)(ws + OFF_WY);
    for (long idx = (long)vb * 256 + VT; idx < 32L * 64 * 64; idx += (long)nvb * 256) {
      const int g = (int)(idx >> 12), i = (int)(idx >> 6) & 63, p = (int)idx & 63;
      const float dt = expf(P.log_dt[g]);
      const float ar = P.a_re[g * 64 + p], ai = P.a_im[g * 64 + p];
      const float d = (float)(i + 1);
      const float2 E = cexpf2(ar * dt * d, ai * dt * d);
#pragma unroll
      for (int h = 0; h < 16; ++h) {
        const float2 z = cmul(make_float2(P.c_re[(g * 16 + h) * 64 + p], P.c_im[(g * 16 + h) * 64 + p]), E);
        *reinterpret_cast<unsigned*>(Wy + ((long)g * 1024 + i * 16 + h) * UGLD + 1024 + 2 * p) = pack2bf(z.x, -z.y);
      }
    }
  }
    }
  }
}

DI void phase3(const Params& P, char* smem) {
  char* ws = P.ws;
  {
    u16* UG = (u16*)(ws + OFF_UG); const float* Sloc = (const float*)(ws + OFF_SLOC);
    for (int id = VB * 256 + VT; id < 8192; id += NVB * 256) {
      const int p = id & 63, b = (id >> 6) & 3, g = id >> 8;
      const float dt = expf(P.log_dt[g]);
      const float ar = P.a_re[g * 64 + p], ai = P.a_im[g * 64 + p];
      const float2 lamT = cexpf2(ar * dt * 64.f, ai * dt * 64.f);
      float2 s = make_float2(0.f, 0.f);
      for (int c0 = 0; c0 < 128; c0 += 16) {
        const long m0 = (long)g * 512 + b * 128 + c0;
        float2 loc[16];
#pragma unroll
        for (int k = 0; k < 16; ++k) loc[k] = *reinterpret_cast<const float2*>(Sloc + (m0 + k) * 128 + 2 * p);
#pragma unroll
        for (int k = 0; k < 16; ++k) {
          *reinterpret_cast<unsigned*>(UG + (m0 + k) * UGLD + 1024 + 2 * p) = pack2bf(s.x, s.y);
          s = cmul(lamT, s); s.x += loc[k].x; s.y += loc[k].y;
        }
      }
    }
  }
  {
    const u16* Qb = (const u16*)(ws + OFF_QB);
    const float* kmean = (const float*)(ws + OFF_KMEAN);
    int* gcount = (int*)(ws + OFF_GCOUNT);
    u16* list = (u16*)(ws + OFF_LIST);
    float* km = (float*)smem;
    int* cnt = (int*)(smem + 31 * 64 * 4);
    int* base = cnt + 32;
    for (int item0 = RBLK * 2; item0 < 1024; item0 += RGRID * 2) {
      const int item = item0 + VHALF;
      const int bh = item >> 5, own = (item & 512) ? 31 - (item & 31) : (item & 31), b = bh >> 3, h = bh & 7, tid = VT;
      const bool act = own > 0;
      if (act) for (int i = tid; i < own * 64; i += 256) km[i] = kmean[bh * 32 * 64 + i];
      if (tid < 32) cnt[tid] = 0;
      __syncthreads();
      const int l = own * 256 + tid;
      float v0 = -3e38f, v1 = -3e38f, v2 = -3e38f; int n0 = 0, n1 = 0, n2 = 0;
      if (act) {
        const u16* qrow = Qb + ((long)(b * 8192 + l)) * 512 + h * 64;
        float q[64];
#pragma unroll
        for (int c8 = 0; c8 < 8; ++c8) {
          uint4 w = *reinterpret_cast<const uint4*>(qrow + c8 * 8);
          q[c8 * 8 + 0] = __uint_as_float(w.x << 16); q[c8 * 8 + 1] = __uint_as_float(w.x & 0xffff0000u);
          q[c8 * 8 + 2] = __uint_as_float(w.y << 16); q[c8 * 8 + 3] = __uint_as_float(w.y & 0xffff0000u);
          q[c8 * 8 + 4] = __uint_as_float(w.z << 16); q[c8 * 8 + 5] = __uint_as_float(w.z & 0xffff0000u);
          q[c8 * 8 + 6] = __uint_as_float(w.w << 16); q[c8 * 8 + 7] = __uint_as_float(w.w & 0xffff0000u);
        }
        for (int n = 0; n < own; ++n) {
          float sacc = 0.f;
#pragma unroll
          for (int d = 0; d < 64; ++d) sacc += q[d] * km[n * 64 + d];
          if (sacc > v2) {
            if (sacc > v1) { v2 = v1; n2 = n1; if (sacc > v0) { v1 = v0; n1 = n0; v0 = sacc; n0 = n; } else { v1 = sacc; n1 = n; } }
            else { v2 = sacc; n2 = n; }
          }
        }
      }
      const int nsel = own < 3 ? own : 3;
      int p0 = 0, p1 = 0, p2 = 0;
      if (nsel > 0) p0 = atomicAdd(&cnt[n0], 1);
      if (nsel > 1) p1 = atomicAdd(&cnt[n1], 1);
      if (nsel > 2) p2 = atomicAdd(&cnt[n2], 1);
      __syncthreads();
      if (tid < 32) base[tid] = cnt[tid] > 0 ? atomicAdd(&gcount[bh * 32 + tid], cnt[tid]) : 0;
      __syncthreads();
      if (nsel > 0) list[((long)(bh * 32 + n0)) * 8192 + base[n0] + p0] = (u16)((l << 2) | 0);
      if (nsel > 1) list[((long)(bh * 32 + n1)) * 8192 + base[n1] + p1] = (u16)((l << 2) | 1);
      if (nsel > 2) list[((long)(bh * 32 + n2)) * 8192 + base[n2] + p2] = (u16)((l << 2) | 2);
      __syncthreads();
    }
  }
  {
    const bool part = RGRID > 16;
    if (!part || RBLK >= 16) {
      const int tvb = part ? (RBLK - 16) * 2 + VHALF : VB, tnvb = part ? (RGRID - 16) * 2 : NVB;
    const float* Ktab = (const float*)(ws + OFF_KTAB);
    u16* Wy = (u16*)(ws + OFF_WY);
    for (long idx = (long)tvb * 256 + VT; idx < 32L * 1024 * 128; idx += (long)tnvb * 256) {
      int g = (int)(idx >> 17), n = (int)(idx >> 7) & 1023, k8 = (int)idx & 127, i = n >> 4, h = n & 15, j = k8 >> 1, hp0 = (k8 & 1) * 8;
      if (k8 * 8 >= ((n >> 7) + 1) * 128) continue;
      uint4 o = make_uint4(0, 0, 0, 0);
      if (j <= i) {
        const float4* kp = reinterpret_cast<const float4*>(Ktab + ((g * 64 + (i - j)) * 16 + h) * 16 + hp0);
        float4 a = kp[0], b = kp[1];
        o = make_uint4(pack2bf(a.x, a.y), pack2bf(a.z, a.w), pack2bf(b.x, b.y), pack2bf(b.z, b.w));
      }
      *reinterpret_cast<uint4*>(Wy + ((long)g * 1024 + n) * UGLD + k8 * 8) = o;
    }
    }
  }
}

DI float xor32_max(float v) { const auto r = __builtin_amdgcn_permlane32_swap(__float_as_uint(v), __float_as_uint(v), false, false); return fmaxf(__uint_as_float(r[0]), __uint_as_float(r[1])); }
DI float xor32_sum(float v) { const auto r = __builtin_amdgcn_permlane32_swap(__float_as_uint(v), __float_as_uint(v), false, false); return __uint_as_float(r[0]) + __uint_as_float(r[1]); }
DI int crow(int i, int hh) { return (i & 3) + 8 * (i >> 2) + 4 * hh; }

DI void attn_task(const Params& P, int bh, int n, int t, int lane, const char* Ks, const char* Vs) {
  char* ws = P.ws;
  const u16* Qb = (const u16*)(ws + OFF_QB);
  const int* gcount = (const int*)(ws + OFF_GCOUNT); const u16* list = (const u16*)(ws + OFF_LIST);
  u16* Opart = (u16*)(ws + OFF_OPART); float* Lse = (float*)(ws + OFF_LSE);
  const int b = bh >> 3, h = bh & 7, r = lane & 31, hh = lane >> 5;
  const bool own = t < 8;
  int lq, slot; bool valid = true;
  if (own) { lq = n * 256 + t * 32 + r; slot = 3; }
  else {
    const int cnt = gcount[bh * 32 + n], idx = (t - 8) * 32 + r;
    valid = idx < cnt;
    const int e = list[((long)(bh * 32 + n)) * 8192 + (valid ? idx : 0)];
    lq = e >> 2; slot = e & 3;
  }
  bf16x8 qf[4];
  {
    const u16* qrow = Qb + ((long)(b * 8192 + lq)) * 512 + h * 64 + 8 * hh;
#pragma unroll
    for (int s = 0; s < 4; ++s) qf[s] = *reinterpret_cast<const bf16x8*>(qrow + 16 * s);
  }
  float m_run = -1e30f, l_run = 0.f;
  f32x16 O0, O1;
#pragma unroll
  for (int i = 0; i < 16; ++i) { O0[i] = 0.f; O1[i] = 0.f; }
  const int nkt = own ? (t + 1) : 8;
  for (int kt = 0; kt < nkt; ++kt) {
    const int kbase = n * 256 + kt * 32;
    const int krow = kt * 32 + r;
    f32x16 S;
#pragma unroll
    for (int i = 0; i < 16; ++i) S[i] = 0.f;
#pragma unroll
    for (int s = 0; s < 4; ++s) {
      const bf16x8 kf = *reinterpret_cast<const bf16x8*>(Ks + krow * 128 + (((2 * s + hh) ^ ((krow >> 1) & 7)) * 16));
      S = __builtin_amdgcn_mfma_f32_32x32x16_bf16(kf, qf[s], S, 0, 0, 0);
    }
    const bool diag = own && (kt == t);
    constexpr float SC2 = 0.125f * 1.4426950408889634f;
    float mx = -1e30f;
#pragma unroll
    for (int i = 0; i < 16; ++i) {
      if (diag && (kbase + crow(i, hh) > lq)) S[i] = -1e30f;
      mx = fmaxf(mx, S[i]);
    }
    mx = xor32_max(mx);
    const float m_new = fmaxf(m_run, mx * SC2);
    const float alpha = __builtin_amdgcn_exp2f(m_run - m_new);
    float rs = 0.f;
#pragma unroll
    for (int i = 0; i < 16; ++i) { float pv = __builtin_amdgcn_exp2f(fmaf(S[i], SC2, -m_new)); S[i] = pv; rs += pv; }
    rs = xor32_sum(rs);
    l_run = l_run * alpha + rs; m_run = m_new;
    if (__ballot(alpha != 1.f)) {
#pragma unroll
      for (int i = 0; i < 16; ++i) { O0[i] *= alpha; O1[i] *= alpha; }
    }
#pragma unroll
    for (int s = 0; s < 2; ++s) {
      const uint4 ppk = make_uint4(pack2bf(S[8 * s], S[8 * s + 1]), pack2bf(S[8 * s + 2], S[8 * s + 3]), pack2bf(S[8 * s + 4], S[8 * s + 5]), pack2bf(S[8 * s + 6], S[8 * s + 7]));
      const bf16x8 pf = __builtin_bit_cast(bf16x8, ppk);
#pragma unroll
      for (int dt = 0; dt < 2; ++dt) {
        const char* vp = Vs + (dt * 32 + r) * 528 + (kt * 32 + 16 * s + 4 * hh) * 2;
        const uint2 lo = *reinterpret_cast<const uint2*>(vp), hi = *reinterpret_cast<const uint2*>(vp + 16);
        const uint4 vv = make_uint4(lo.x, lo.y, hi.x, hi.y);
        if (dt == 0) O0 = __builtin_amdgcn_mfma_f32_32x32x16_bf16(__builtin_bit_cast(bf16x8, vv), pf, O0, 0, 0, 0);
        else O1 = __builtin_amdgcn_mfma_f32_32x32x16_bf16(__builtin_bit_cast(bf16x8, vv), pf, O1, 0, 0, 0);
      }
    }
  }
  if (valid) {
    const float inv = 1.f / l_run;
    const long rowid = ((long)(b * 8192 + lq) * 8 + h) * 4 + slot;
    u16* op = Opart + rowid * 64;
#pragma unroll
    for (int gq = 0; gq < 4; ++gq) {
      *reinterpret_cast<uint2*>(op + 8 * gq + 4 * hh) = make_uint2(pack2bf(O0[4 * gq] * inv, O0[4 * gq + 1] * inv), pack2bf(O0[4 * gq + 2] * inv, O0[4 * gq + 3] * inv));
      *reinterpret_cast<uint2*>(op + 32 + 8 * gq + 4 * hh) = make_uint2(pack2bf(O1[4 * gq] * inv, O1[4 * gq + 1] * inv), pack2bf(O1[4 * gq + 2] * inv, O1[4 * gq + 3] * inv));
    }
    if (hh == 0) Lse[rowid] = (m_run + __log2f(l_run)) * 0.6931471805599453f;
  }
}

DI void phase4(const Params& P, char* smem) {
  char* ws = P.ws;
  const u16* UG = (const u16*)(ws + OFF_UG); const u16* Wy = (const u16*)(ws + OFF_WY);
  u16* Yb = (u16*)(ws + OFF_YB);
  TILE_LOOP(tile, 32 * 4 * 8, 8) {
    const int trow = tile >> 3, g = (trow >> 5) * 8 + (tile & 7), brow = (trow & 3) * 128, cidx = (trow >> 2) & 7, bcol = ((trow & 64) ? 7 - cidx : cidx) * 128;
    gemm_tile<true>(UG + ((long)g * 512 + brow) * UGLD, UGLD, Wy + ((long)g * 1024 + bcol) * UGLD, UGLD, 0, (bcol + 128) / 64, 16, 18, smem, [&](int row, int col0, f32x4 v) {
      const int n = bcol + col0, i = n >> 4, h = n & 15, m = brow + row;
      const float4 dsk = *reinterpret_cast<const float4*>(P.dsk + g * 16 + h);
      const uint2 uu = *reinterpret_cast<const uint2*>(UG + ((long)g * 512 + m) * UGLD + n);
      const float y0 = gelu_t(v[0] + dsk.x * __uint_as_float(uu.x << 16)), y1 = gelu_t(v[1] + dsk.y * __uint_as_float(uu.x & 0xffff0000u));
      const float y2 = gelu_t(v[2] + dsk.z * __uint_as_float(uu.y << 16)), y3 = gelu_t(v[3] + dsk.w * __uint_as_float(uu.y & 0xffff0000u));
      *reinterpret_cast<uint2*>(Yb + ((long)m * 64 + i) * 512 + g * 16 + h) = make_uint2(pack2bf(y0, y1), pack2bf(y2, y3));
    });
  }
  const int wid = VT >> 6, lane = VT & 63, tid = VT;
  const int* gcount = (const int*)(ws + OFF_GCOUNT);
  const u16* Kb = (const u16*)(ws + OFF_KB); const u16* Vt = (const u16*)(ws + OFF_VT);
  char* Ks = smem; char* Vs = smem + 32768;
  int* pre = (int*)(smem + 32768 + 33792);
  int* part = pre + 1032;
  __syncthreads();
  {
    if (tid < 32) { int s = 0; for (int k = 0; k < 32; ++k) s += (4 + ((gcount[tid * 32 + k] + 31) >> 5) + 7) >> 3; part[tid + 1] = s; }
    __syncthreads();
    if (tid == 0) { part[0] = 0; for (int k = 1; k <= 32; ++k) part[k] += part[k - 1]; }
    __syncthreads();
    if (tid < 32) { int s = part[tid]; for (int k = 0; k < 32; ++k) { pre[tid * 32 + k] = s; s += (4 + ((gcount[tid * 32 + k] + 31) >> 5) + 7) >> 3; } }
    if (tid == 0) pre[1024] = part[32];
    __syncthreads();
  }
  const int total = pre[1024];
  const int per = (total + 7) >> 3, slot = (RBLK >> 3) * 2 + VHALF, nslot = (RGRID >> 3) * 2;
  for (int k0 = 0; k0 < per; k0 += nslot) {
    const int kk = k0 + slot, it_ = (RBLK & 7) * per + kk;
    const bool act = kk < per && it_ < total;
    const int it = act ? it_ : 0;
    int lo = 0, hi = 1024;
    while (hi - lo > 1) { const int mid = (lo + hi) >> 1; if (pre[mid] <= it) lo = mid; else hi = mid; }
    const int bh = lo >> 5, n = lo & 31, b = bh >> 3, h = bh & 7;
    const int ntask = 4 + ((gcount[lo] + 31) >> 5);
    const int task = (it - pre[lo]) * 8 + wid;
    uint4 kr[8], vr[8];
#pragma unroll
    for (int i = 0; i < 8; ++i) {
      const int q = i * 256 + tid;
      kr[i] = *reinterpret_cast<const uint4*>(Kb + ((long)(b * 8192 + n * 256 + (q >> 3))) * 512 + h * 64 + (q & 7) * 8);
      vr[i] = *reinterpret_cast<const uint4*>(Vt + ((long)(bh * 64 + (q >> 5))) * 8192 + n * 256 + (q & 31) * 8);
    }
#pragma unroll
    for (int i = 0; i < 8; ++i) {
      const int q = i * 256 + tid, row = q >> 3;
      *reinterpret_cast<uint4*>(Ks + row * 128 + (((q & 7) ^ ((row >> 1) & 7)) * 16)) = kr[i];
      *reinterpret_cast<uint4*>(Vs + (q >> 5) * 528 + (q & 31) * 16) = vr[i];
    }
    __syncthreads();
    if (act && task < ntask) {
      if (task < 4) { attn_task(P, bh, n, task, lane, Ks, Vs); attn_task(P, bh, n, 7 - task, lane, Ks, Vs); }
      else attn_task(P, bh, n, task - 4 + 8, lane, Ks, Vs);
    }
    if (act && task + 4 < ntask) attn_task(P, bh, n, task + 4 - 4 + 8, lane, Ks, Vs);
    __syncthreads();
  }
}

DI void phase5(const Params& P, char* smem) {
  char* ws = P.ws;
  const u16* Yb = (const u16*)(ws + OFF_YB); const u16* WgT = (const u16*)(ws + OFF_WGT);
  u16* cat = (u16*)(ws + OFF_CAT);
  TILE_LOOP(tile, 256 * 4, 4) {
    const int brow = (tile >> 2) * 128, bcol = (tile & 3) * 128;
    gemm_tile<true>(Yb + (long)brow * 512, 512, WgT + (long)bcol * 512, 512, 0, 8, 0, 0, smem, [&](int row, int col0, f32x4 v) {
      const long r = brow + row; const int c = bcol + col0;
      const uint2 yy = *reinterpret_cast<const uint2*>(Yb + r * 512 + c);
      const float o0 = __uint_as_float(yy.x << 16) / (1.f + __expf(-v[0])), o1 = __uint_as_float(yy.x & 0xffff0000u) / (1.f + __expf(-v[1]));
      const float o2 = __uint_as_float(yy.y << 16) / (1.f + __expf(-v[2])), o3 = __uint_as_float(yy.y & 0xffff0000u) / (1.f + __expf(-v[3]));
      *reinterpret_cast<uint2*>(cat + r * 1024 + c) = make_uint2(pack2bf(o0, o1), pack2bf(o2, o3));
    });
  }
  const u16* Opart = (const u16*)(ws + OFF_OPART); const float* Lse = (const float*)(ws + OFF_LSE);
  for (long idx = (long)VB * 256 + VT; idx < (long)NTOK * 64; idx += (long)NVB * 256) {
    const int dg = (int)idx & 7, h = (int)(idx >> 3) & 7; const long tok = idx >> 6;
    const int l = (int)(tok & 8191); const int ownb = l >> 8; const int nv = ownb < 3 ? ownb : 3;
    const long base = (tok * 8 + h) * 4;
    float ls[4]; float mx = -3e38f;
#pragma unroll
    for (int s = 0; s < 4; ++s) { const bool ok = (s == 3) || (s < nv); ls[s] = ok ? Lse[base + s] : -3e38f; mx = fmaxf(mx, ls[s]); }
    float acc[8]; float wsum = 0.f;
#pragma unroll
    for (int k = 0; k < 8; ++k) acc[k] = 0.f;
#pragma unroll
    for (int s = 0; s < 4; ++s) {
      const bool ok = (s == 3) || (s < nv);
      if (ok) {
        const float w = __expf(ls[s] - mx); wsum += w;
        uint4 o = *reinterpret_cast<const uint4*>(Opart + (base + s) * 64 + dg * 8);
        acc[0] += w * __uint_as_float(o.x << 16); acc[1] += w * __uint_as_float(o.x & 0xffff0000u);
        acc[2] += w * __uint_as_float(o.y << 16); acc[3] += w * __uint_as_float(o.y & 0xffff0000u);
        acc[4] += w * __uint_as_float(o.z << 16); acc[5] += w * __uint_as_float(o.z & 0xffff0000u);
        acc[6] += w * __uint_as_float(o.w << 16); acc[7] += w * __uint_as_float(o.w & 0xffff0000u);
      }
    }
    const float inv = 1.f / wsum;
    *reinterpret_cast<uint4*>(cat + tok * 1024 + 512 + h * 64 + dg * 8) =
        make_uint4(pack2bf(acc[0] * inv, acc[1] * inv), pack2bf(acc[2] * inv, acc[3] * inv), pack2bf(acc[4] * inv, acc[5] * inv), pack2bf(acc[6] * inv, acc[7] * inv));
  }
}

DI void phase6(const Params& P, char* smem) {
  char* ws = P.ws;
  const u16* cat = (const u16*)(ws + OFF_CAT); const u16* WoT = (const u16*)(ws + OFF_WOT);
  float* Z1 = (float*)(ws + OFF_Z1);
  for (int q = RBLK >> 3; q < 64; q += RGRID >> 3) {
    const int brow = (q * 2 + ((RBLK & 7) >> 2)) * 256, bcol = (RBLK & 3) * 256;
    gemm_tile256(cat + (long)brow * 1024, 1024, WoT + (long)bcol * 1024, 1024, 32, smem, [&](int row, int col0, f32x4 v) {
      const long o = (long)(brow + row) * 1024 + bcol + col0;
      const float4 xs = *reinterpret_cast<const float4*>(P.x + o);
      *reinterpret_cast<float4*>(Z1 + o) = make_float4(ALPHA * xs.x + v[0], ALPHA * xs.y + v[1], ALPHA * xs.z + v[2], ALPHA * xs.w + v[3]);
    });
  }
}

DI void phase7(const Params& P, char* smem) {
  char* ws = P.ws;
  const float* Z1 = (const float*)(ws + OFF_Z1);
  _Float16* h1h = (_Float16*)(ws + OFF_H1H); u16* h1b = (u16*)(ws + OFF_H1B);
  const int wid = VT >> 6, lane = VT & 63;
  for (int row = VB * 4 + wid; row < NTOK; row += NVB * 4) {
    float4 z[4]; float s = 0.f;
#pragma unroll
    for (int k = 0; k < 4; ++k) { z[k] = *reinterpret_cast<const float4*>(Z1 + (long)row * 1024 + k * 256 + lane * 4); s += z[k].x + z[k].y + z[k].z + z[k].w; }
    const float mu = wave_sum(s) * (1.f / 1024.f);
    float q = 0.f;
#pragma unroll
    for (int k = 0; k < 4; ++k) { float a = z[k].x - mu, b = z[k].y - mu, c = z[k].z - mu, d = z[k].w - mu; q += a * a + b * b + c * c + d * d; }
    const float rstd = rsqrtf(wave_sum(q) * (1.f / 1024.f) + 1e-5f);
#pragma unroll
    for (int k = 0; k < 4; ++k) {
      const int c0 = k * 256 + lane * 4;
      const float4 gg = *reinterpret_cast<const float4*>(P.ln1g + c0), bb = *reinterpret_cast<const float4*>(P.ln1b + c0);
      const float y0 = (z[k].x - mu) * rstd * gg.x + bb.x, y1 = (z[k].y - mu) * rstd * gg.y + bb.y, y2 = (z[k].z - mu) * rstd * gg.z + bb.z, y3 = (z[k].w - mu) * rstd * gg.w + bb.w;
      typedef _Float16 h4 __attribute__((ext_vector_type(4)));
      h4 hv; hv[0] = (_Float16)y0; hv[1] = (_Float16)y1; hv[2] = (_Float16)y2; hv[3] = (_Float16)y3;
      *reinterpret_cast<h4*>(h1h + (long)row * 1024 + c0) = hv;
      *reinterpret_cast<uint2*>(h1b + (long)row * 1024 + c0) = make_uint2(pack2bf(y0, y1), pack2bf(y2, y3));
      z[k] = make_float4(y0, y1, y2, y3);
    }
    float am = 0.f;
#pragma unroll
    for (int k = 0; k < 4; ++k) am = fmaxf(am, fmaxf(fmaxf(fabsf(z[k].x), fabsf(z[k].y)), fmaxf(fabsf(z[k].z), fabsf(z[k].w))));
    am = wave_max(am);
    const float xinv = am > 0.f ? 127.f / am : 0.f;
#pragma unroll
    for (int k = 0; k < 4; ++k) {
      const unsigned pk = ((unsigned)((int)rintf(z[k].x * xinv) & 0xff)) | ((unsigned)((int)rintf(z[k].y * xinv) & 0xff) << 8) |
                          ((unsigned)((int)rintf(z[k].z * xinv) & 0xff) << 16) | ((unsigned)((int)rintf(z[k].w * xinv) & 0xff) << 24);
      *reinterpret_cast<unsigned*>(ws + OFF_XQ + (long)row * 1024 + k * 256 + lane * 4) = pk;
    }
    if (lane == 0) reinterpret_cast<float*>(ws + OFF_SX)[row] = am * (1.f / 127.f);
  }
  for (int row = VB * 4 + wid; row < 2 * 16384; row += NVB * 4) {
    const bool isv = row >= 16384; const int e = row & 16383;
    const float* src = (isv ? P.pv : P.pu) + (long)e * 1024 + lane * 16;
    float f[16];
#pragma unroll
    for (int k = 0; k < 4; ++k) { const float4 a = reinterpret_cast<const float4*>(src)[k]; f[4 * k] = a.x; f[4 * k + 1] = a.y; f[4 * k + 2] = a.z; f[4 * k + 3] = a.w; }
    float am = 0.f;
#pragma unroll
    for (int k = 0; k < 16; ++k) am = fmaxf(am, fabsf(f[k]));
    am = wave_max(am);
    const float inv = am > 0.f ? 127.f / am : 0.f;
    unsigned w[4];
#pragma unroll
    for (int k = 0; k < 4; ++k) {
      unsigned pk = 0;
#pragma unroll
      for (int b = 0; b < 4; ++b) { int q = (int)rintf(f[4 * k + b] * inv); q = q > 127 ? 127 : (q < -127 ? -127 : q); pk |= ((unsigned)((isv ? q + 128 : q) & 0xff)) << (8 * b); }
      w[k] = pk;
    }
    *reinterpret_cast<uint4*>(ws + (isv ? OFF_VQ + ((long)(lane >> 3) * 16384 + e) * 128 + (lane & 7) * 16 : OFF_UQ + (long)e * 1024 + lane * 16)) = make_uint4(w[0], w[1], w[2], w[3]);
    if (lane == 0) reinterpret_cast<float*>(ws + (isv ? OFF_VS : OFF_US))[e] = am * (1.f / 127.f);
  }
}

DI void phase8(const Params& P, char* smem) {
  char* ws = P.ws;
  const u16* h1b = (const u16*)(ws + OFF_H1B); const u16* WqT = (const u16*)(ws + OFF_WQT);
  u16* Qp = (u16*)(ws + OFF_QP);
  for (int q = RBLK >> 3; q < 128; q += RGRID >> 3) {
    const int brow = q * 256, bcol = (RBLK & 7) * 256;
    gemm_tile256(h1b + (long)brow * 1024, 1024, WqT + (long)bcol * 1024, 1024, 32, smem, [&](int row, int col0, f32x4 v) {
      *reinterpret_cast<uint2*>(Qp + (long)(brow + row) * 2048 + bcol + col0) = make_uint2(pack2bf(v[0], v[1]), pack2bf(v[2], v[3]));
    });
  }
}

DI void phase9(const Params& P, char* smem) {
  char* ws = P.ws;
  const u16* Qp = (const u16*)(ws + OFF_QP); const u16* SKb = (const u16*)(ws + OFF_SKB);
  _Float16* ST = (_Float16*)(ws + OFF_ST);
  TILE_LOOP(tile, 256 * 16, 16) {
    const int brow = (tile >> 4) * 128, hc = tile & 15;
    gemm_tile<false>(Qp + (long)brow * 2048 + hc * 128, 2048, SKb + (long)hc * 128 * 128, 128, 0, 2, 0, 0, smem, [&](int row0, int col, f32x4 v) {
      typedef _Float16 h4 __attribute__((ext_vector_type(4)));
      h4 hv; hv[0] = (_Float16)v[0]; hv[1] = (_Float16)v[1]; hv[2] = (_Float16)v[2]; hv[3] = (_Float16)v[3];
      *reinterpret_cast<h4*>(ST + ((long)(hc * 128 + col)) * NTOK + brow + row0) = hv;
    });
  }
}

DI unsigned umax_(unsigned a, unsigned b) { return a > b ? a : b; }
DI unsigned umin_(unsigned a, unsigned b) { return a < b ? a : b; }
#define CE(a, b) { const unsigned hi_ = umax_(a, b), lo_ = umin_(a, b); a = hi_; b = lo_; }
#define SORT16(A) CE(A[0],A[1]) CE(A[2],A[3]) CE(A[4],A[5]) CE(A[6],A[7]) CE(A[8],A[9]) CE(A[10],A[11]) CE(A[12],A[13]) CE(A[14],A[15]) CE(A[0],A[2]) CE(A[1],A[3]) CE(A[4],A[6]) CE(A[5],A[7]) CE(A[8],A[10]) CE(A[9],A[11]) CE(A[12],A[14]) CE(A[13],A[15]) CE(A[1],A[2]) CE(A[5],A[6]) CE(A[9],A[10]) CE(A[13],A[14]) CE(A[0],A[4]) CE(A[1],A[5]) CE(A[2],A[6]) CE(A[3],A[7]) CE(A[8],A[12]) CE(A[9],A[13]) CE(A[10],A[14]) CE(A[11],A[15]) CE(A[2],A[4]) CE(A[3],A[5]) CE(A[10],A[12]) CE(A[11],A[13]) CE(A[1],A[2]) CE(A[3],A[4]) CE(A[5],A[6]) CE(A[9],A[10]) CE(A[11],A[12]) CE(A[13],A[14]) CE(A[0],A[8]) CE(A[1],A[9]) CE(A[2],A[10]) CE(A[3],A[11]) CE(A[4],A[12]) CE(A[5],A[13]) CE(A[6],A[14]) CE(A[7],A[15]) CE(A[4],A[8]) CE(A[5],A[9]) CE(A[6],A[10]) CE(A[7],A[11]) CE(A[2],A[4]) CE(A[3],A[5]) CE(A[6],A[8]) CE(A[7],A[9]) CE(A[10],A[12]) CE(A[11],A[13]) CE(A[1],A[2]) CE(A[3],A[4]) CE(A[5],A[6]) CE(A[7],A[8]) CE(A[9],A[10]) CE(A[11],A[12]) CE(A[13],A[14])
#define MERGE16(R,G) R[0]=umax_(R[0],G[15]); R[1]=umax_(R[1],G[14]); R[2]=umax_(R[2],G[13]); R[3]=umax_(R[3],G[12]); R[4]=umax_(R[4],G[11]); R[5]=umax_(R[5],G[10]); R[6]=umax_(R[6],G[9]); R[7]=umax_(R[7],G[8]); R[8]=umax_(R[8],G[7]); R[9]=umax_(R[9],G[6]); R[10]=umax_(R[10],G[5]); R[11]=umax_(R[11],G[4]); R[12]=umax_(R[12],G[3]); R[13]=umax_(R[13],G[2]); R[14]=umax_(R[14],G[1]); R[15]=umax_(R[15],G[0]); CE(R[0],R[8]) CE(R[1],R[9]) CE(R[2],R[10]) CE(R[3],R[11]) CE(R[4],R[12]) CE(R[5],R[13]) CE(R[6],R[14]) CE(R[7],R[15]) CE(R[0],R[4]) CE(R[1],R[5]) CE(R[2],R[6]) CE(R[3],R[7]) CE(R[8],R[12]) CE(R[9],R[13]) CE(R[10],R[14]) CE(R[11],R[15]) CE(R[0],R[2]) CE(R[1],R[3]) CE(R[4],R[6]) CE(R[5],R[7]) CE(R[8],R[10]) CE(R[9],R[11]) CE(R[12],R[14]) CE(R[13],R[15]) CE(R[0],R[1]) CE(R[2],R[3]) CE(R[4],R[5]) CE(R[6],R[7]) CE(R[8],R[9]) CE(R[10],R[11]) CE(R[12],R[13]) CE(R[14],R[15])

DI void topk_half(const _Float16* __restrict__ sp, unsigned (&R)[16]) {
#pragma unroll
  for (int e = 0; e < 16; ++e) R[e] = 0u;
#pragma unroll 1
  for (int gi = 0; gi < 8; ++gi) {
    unsigned Gk[16];
#pragma unroll
    for (int e = 0; e < 16; ++e) {
      const int n = gi * 16 + e;
      const unsigned bits = __builtin_bit_cast(unsigned short, sp[(long)n * NTOK]);
      const unsigned o = (bits & 0x8000u) ? (~bits & 0xffffu) : (bits | 0x8000u);
      Gk[e] = (o << 16) | (unsigned)(127 - n);
    }
    SORT16(Gk)
    MERGE16(R, Gk)
  }
}
DI float key_val16(unsigned k) { const unsigned o = k >> 16; const unsigned short b = (unsigned short)((o & 0x8000u) ? (o & 0x7fffu) : (~o & 0xffffu)); return (float)__builtin_bit_cast(_Float16, b); }
DI unsigned candkey(float s, int pos) { const unsigned b = __float_as_uint(s); const unsigned o = (b >> 31) ? ~b : (b ^ 0x80000000u); return (o & 0xffffff00u) | (unsigned)(255 - pos); }
DI unsigned lut4(const unsigned (&W)[4], int a) { const int j = a >> 2; const unsigned w = j == 0 ? W[0] : (j == 1 ? W[1] : (j == 2 ? W[2] : W[3])); return (w >> ((a & 3) * 8)) & 0xffu; }

DI void phase10(const Params& P, char* smem) {
  char* ws = P.ws;
  const _Float16* ST = (const _Float16*)(ws + OFF_ST);
  int* Eidx = (int*)(ws + OFF_EIDX); float* G = (float*)(ws + OFF_G);
  for (long id = (long)VB * 256 + VT; id < (long)NTOK * 8; id += (long)NVB * 256) {
    const int t = (int)(id & (NTOK - 1)), h = (int)(id >> 15);
    unsigned R1[16], R2[16];
    topk_half(ST + ((long)(h * 2 + 0) * 128) * NTOK + t, R1);
    topk_half(ST + ((long)(h * 2 + 1) * 128) * NTOK + t, R2);
    float v1[16], v2[16]; unsigned W1[4] = {0u, 0u, 0u, 0u}, W2[4] = {0u, 0u, 0u, 0u};
#pragma unroll
    for (int k = 0; k < 16; ++k) {
      v1[k] = key_val16(R1[k]); v2[k] = key_val16(R2[k]);
      W1[k >> 2] |= (127u - (R1[k] & 127u)) << ((k & 3) * 8);
      W2[k >> 2] |= (127u - (R2[k] & 127u)) << ((k & 3) * 8);
    }
    unsigned C0[16], C1[16], C2[16], C3[16];
    C0[0] = candkey(v1[0] + v2[0], 0);
    C0[1] = candkey(v1[0] + v2[1], 1);
    C0[2] = candkey(v1[0] + v2[2], 2);
    C0[3] = candkey(v1[0] + v2[3], 3);
    C0[4] = candkey(v1[0] + v2[4], 4);
    C0[5] = candkey(v1[0] + v2[5], 5);
    C0[6] = candkey(v1[0] + v2[6], 6);
    C0[7] = candkey(v1[0] + v2[7], 7);
    C0[8] = candkey(v1[0] + v2[8], 8);
    C0[9] = candkey(v1[0] + v2[9], 9);
    C0[10] = candkey(v1[0] + v2[10], 10);
    C0[11] = candkey(v1[0] + v2[11], 11);
    C0[12] = candkey(v1[0] + v2[12], 12);
    C0[13] = candkey(v1[0] + v2[13], 13);
    C0[14] = candkey(v1[0] + v2[14], 14);
    C0[15] = candkey(v1[0] + v2[15], 15);
    C1[0] = candkey(v1[1] + v2[0], 16);
    C1[1] = candkey(v1[1] + v2[1], 17);
    C1[2] = candkey(v1[1] + v2[2], 18);
    C1[3] = candkey(v1[1] + v2[3], 19);
    C1[4] = candkey(v1[1] + v2[4], 20);
    C1[5] = candkey(v1[1] + v2[5], 21);
    C1[6] = candkey(v1[1] + v2[6], 22);
    C1[7] = candkey(v1[1] + v2[7], 23);
    C1[8] = candkey(v1[2] + v2[0], 32);
    C1[9] = candkey(v1[2] + v2[1], 33);
    C1[10] = candkey(v1[2] + v2[2], 34);
    C1[11] = candkey(v1[2] + v2[3], 35);
    C1[12] = candkey(v1[2] + v2[4], 36);
    C1[13] = candkey(v1[3] + v2[0], 48);
    C1[14] = candkey(v1[3] + v2[1], 49);
    C1[15] = candkey(v1[3] + v2[2], 50);
    C2[0] = candkey(v1[3] + v2[3], 51);
    C2[1] = candkey(v1[4] + v2[0], 64);
    C2[2] = candkey(v1[4] + v2[1], 65);
    C2[3] = candkey(v1[4] + v2[2], 66);
    C2[4] = candkey(v1[5] + v2[0], 80);
    C2[5] = candkey(v1[5] + v2[1], 81);
    C2[6] = candkey(v1[6] + v2[0], 96);
    C2[7] = candkey(v1[6] + v2[1], 97);
    C2[8] = candkey(v1[7] + v2[0], 112);
    C2[9] = candkey(v1[7] + v2[1], 113);
    C2[10] = candkey(v1[8] + v2[0], 128);
    C2[11] = candkey(v1[9] + v2[0], 144);
    C2[12] = candkey(v1[10] + v2[0], 160);
    C2[13] = candkey(v1[11] + v2[0], 176);
    C2[14] = candkey(v1[12] + v2[0], 192);
    C2[15] = candkey(v1[13] + v2[0], 208);
    C3[0] = candkey(v1[14] + v2[0], 224);
    C3[1] = candkey(v1[15] + v2[0], 240);
    C3[2] = 0u;
    C3[3] = 0u;
    C3[4] = 0u;
    C3[5] = 0u;
    C3[6] = 0u;
    C3[7] = 0u;
    C3[8] = 0u;
    C3[9] = 0u;
    C3[10] = 0u;
    C3[11] = 0u;
    C3[12] = 0u;
    C3[13] = 0u;
    C3[14] = 0u;
    C3[15] = 0u;
    SORT16(C1) SORT16(C2) SORT16(C3)
    MERGE16(C0, C1) MERGE16(C0, C2) MERGE16(C0, C3)
    float e[16]; int te[16]; float sum = 0.f;
    const float tv0 = [&]() { const unsigned o = C0[0] & 0xffffff00u; return __uint_as_float((o >> 31) ? (o ^ 0x80000000u) : ~o); }();
#pragma unroll
    for (int k = 0; k < 16; ++k) {
      const unsigned key = C0[k]; const unsigned o = key & 0xffffff00u;
      const float val = __uint_as_float((o >> 31) ? (o ^ 0x80000000u) : ~o);
      const int pos = 255 - (int)(key & 255u);
      te[k] = (int)(lut4(W1, pos >> 4) * 128u + lut4(W2, pos & 15));
      e[k] = __expf(val - tv0); sum += e[k];
    }
    const float inv = 1.f / sum;
    int4* ep = reinterpret_cast<int4*>(Eidx + ((long)t * 8 + h) * 16);
    float4* gp = reinterpret_cast<float4*>(G + ((long)t * 8 + h) * 16);
#pragma unroll
    for (int k = 0; k < 4; ++k) {
      ep[k] = make_int4(te[4 * k], te[4 * k + 1], te[4 * k + 2], te[4 * k + 3]);
      gp[k] = make_float4(e[4 * k] * inv, e[4 * k + 1] * inv, e[4 * k + 2] * inv, e[4 * k + 3] * inv);
    }
  }
}

DI int dpp_row_sum_i(int v) {
  v += __builtin_amdgcn_update_dpp(0, v, 0xB1, 0xF, 0xF, true);
  v += __builtin_amdgcn_update_dpp(0, v, 0x4E, 0xF, 0xF, true);
  v += __builtin_amdgcn_update_dpp(0, v, 0x141, 0xF, 0xF, true);
  v += __builtin_amdgcn_update_dpp(0, v, 0x140, 0xF, 0xF, true);
  return v;
}
DI int wave_sum_i(int v) { v = dpp_row_sum_i(v); return __builtin_amdgcn_readlane(v, 0) + __builtin_amdgcn_readlane(v, 16) + __builtin_amdgcn_readlane(v, 32) + __builtin_amdgcn_readlane(v, 48); }

DI void phase11a(const Params& P, char* smem_all) {
  char* ws = P.ws;
  const char* Uq = ws + OFF_UQ; const float* Us = (const float*)(ws + OFF_US); const float* Vs = (const float*)(ws + OFF_VS);
  const int* Eidx = (const int*)(ws + OFF_EIDX); const float* G = (const float*)(ws + OFF_G);
  const char* xq = ws + OFF_XQ; const float* sxp = (const float*)(ws + OFF_SX);
  float* W2 = (float*)(ws + OFF_W2); int* E2 = (int*)(ws + OFF_E2);
  const int j = RBLK & 7, lane = RTID & 63, wslot = (RBLK >> 3) * 8 + (RTID >> 6), nw = (RGRID >> 3) * 8;
  const int l16 = lane & 15, rg = lane >> 4;
  uint2* lst = (uint2*)(smem_all + (RTID >> 6) * 1024);
  int nE0 = Eidx[(long)wslot * 128 + lane], nE1 = Eidx[(long)wslot * 128 + 64 + lane];
  float nG0 = G[(long)wslot * 128 + lane], nG1 = G[(long)wslot * 128 + 64 + lane];
  uint4 nx[4];
#pragma unroll
  for (int c = 0; c < 4; ++c) nx[c] = *reinterpret_cast<const uint4*>(xq + (long)wslot * 1024 + (c * 16 + l16) * 16);
  float nsx = sxp[wslot];
  for (int t = wslot; t < NTOK; t += nw) {
    const int E0 = nE0, E1 = nE1; const float G0 = nG0, G1 = nG1, sx = nsx;
    uint4 xr[4];
#pragma unroll
    for (int c = 0; c < 4; ++c) xr[c] = nx[c];
    bool pf = false;
    const int tn = t + nw < NTOK ? t + nw : t;
    if (j == 0) { E2[(long)t * 128 + (lane & 7) * 16 + (lane >> 3)] = E0; E2[(long)t * 128 + (lane & 7) * 16 + 8 + (lane >> 3)] = E1; }
    const bool in0 = (E0 >> 11) == j, in1 = (E1 >> 11) == j;
    const unsigned long long m0 = __ballot(in0), m1 = __ballot(in1);
    const int c0 = __popcll(m0), cnt = c0 + __popcll(m1);
    const int r0 = __builtin_amdgcn_mbcnt_hi((unsigned)(m0 >> 32), __builtin_amdgcn_mbcnt_lo((unsigned)m0, 0u));
    const int r1 = c0 + __builtin_amdgcn_mbcnt_hi((unsigned)(m1 >> 32), __builtin_amdgcn_mbcnt_lo((unsigned)m1, 0u));
    if (in0) lst[r0] = make_uint2((unsigned)E0 | ((unsigned)lane << 14), __float_as_uint(G0));
    if (in1) lst[r1] = make_uint2((unsigned)E1 | ((unsigned)(64 + lane) << 14), __float_as_uint(G1));
    for (int g0 = 0; g0 < cnt; g0 += 24) {
      const int rem = cnt - g0, ng = rem >= 24 ? 6 : (rem + 3) >> 2;
      int el[6], pl[6]; float gl[6];
#pragma unroll
      for (int gi = 0; gi < 6; ++gi) {
        const int idx = g0 + 4 * gi + rg; const bool ok = idx < cnt;
        const uint2 en = lst[ok ? idx : 0];
        el[gi] = ok ? (int)(en.x & 16383u) : 0; pl[gi] = ok ? (int)(en.x >> 14) : -1; gl[gi] = ok ? __uint_as_float(en.y) : 0.f;
      }
      uint4 u[6][4]; float su[6], sv[6];
#pragma unroll
      for (int gi = 0; gi < 6; ++gi) {
        if (gi < ng) {
          const char* rowp = Uq + (long)el[gi] * 1024 + l16 * 16;
#pragma unroll
          for (int c = 0; c < 4; ++c) u[gi][c] = *reinterpret_cast<const uint4*>(rowp + c * 256);
          su[gi] = Us[el[gi]]; sv[gi] = Vs[el[gi]];
        }
      }
      if (!pf) {
        pf = true;
        nE0 = Eidx[(long)tn * 128 + lane]; nE1 = Eidx[(long)tn * 128 + 64 + lane];
        nG0 = G[(long)tn * 128 + lane]; nG1 = G[(long)tn * 128 + 64 + lane];
#pragma unroll
        for (int c = 0; c < 4; ++c) nx[c] = *reinterpret_cast<const uint4*>(xq + (long)tn * 1024 + (c * 16 + l16) * 16);
        nsx = sxp[tn];
      }
#pragma unroll
      for (int gi = 0; gi < 6; ++gi) {
        if (gi < ng) {
          int d = 0;
#pragma unroll
          for (int c = 0; c < 4; ++c) {
            d = __builtin_amdgcn_sdot4((int)u[gi][c].x, (int)xr[c].x, d, false);
            d = __builtin_amdgcn_sdot4((int)u[gi][c].y, (int)xr[c].y, d, false);
            d = __builtin_amdgcn_sdot4((int)u[gi][c].z, (int)xr[c].z, d, false);
            d = __builtin_amdgcn_sdot4((int)u[gi][c].w, (int)xr[c].w, d, false);
          }
          d = dpp_row_sum_i(d);
          const float dot = (float)d * (su[gi] * sx);
          const float w = gl[gi] * gelu_t(dot) * sv[gi];
          const int p = pl[gi];
          if (l16 == 0 && p >= 0) W2[(long)t * 128 + (p & 7) * 16 + (p >> 3)] = w;
        }
      }
    }
    if (!pf) {
      nE0 = Eidx[(long)tn * 128 + lane]; nE1 = Eidx[(long)tn * 128 + 64 + lane];
      nG0 = G[(long)tn * 128 + lane]; nG1 = G[(long)tn * 128 + 64 + lane];
#pragma unroll
      for (int c = 0; c < 4; ++c) nx[c] = *reinterpret_cast<const uint4*>(xq + (long)tn * 1024 + (c * 16 + l16) * 16);
      nsx = sxp[tn];
    }
  }
}

DI float dpp_row_sum_f(float v) {
  v += __int_as_float(__builtin_amdgcn_update_dpp(0, __float_as_int(v), 0xB1, 0xF, 0xF, true));
  v += __int_as_float(__builtin_amdgcn_update_dpp(0, __float_as_int(v), 0x4E, 0xF, 0xF, true));
  v += __int_as_float(__builtin_amdgcn_update_dpp(0, __float_as_int(v), 0x141, 0xF, 0xF, true));
  v += __int_as_float(__builtin_amdgcn_update_dpp(0, __float_as_int(v), 0x140, 0xF, 0xF, true));
  return v;
}
DI void phase11b(const Params& P, char* smem_all) {
  char* ws = P.ws;
  const char* Vq = ws + OFF_VQ;
  const float* W2 = (const float*)(ws + OFF_W2); const int* E2 = (const int*)(ws + OFF_E2);
  _Float16* Zp = (_Float16*)(ws + OFF_ZP);
  const int j = RBLK & 7, lane = RTID & 63, wv = RTID >> 6, wslot = (RBLK >> 3) * 8 + wv, nw = (RGRID >> 3) * 8;
  float* red = (float*)(smem_all + wv * 4096);
  const char* vbase = Vq + (long)j * 16384 * 128 + (lane & 7) * 16;
  const int g8 = lane >> 3;
  int4 en[4]; float4 wn[4];
  auto load_list = [&](int t) {
#pragma unroll
    for (int k = 0; k < 4; ++k) {
      en[k] = *reinterpret_cast<const int4*>(E2 + (long)t * 128 + g8 * 16 + 4 * k);
      wn[k] = *reinterpret_cast<const float4*>(W2 + (long)t * 128 + g8 * 16 + 4 * k);
    }
  };
  auto gather = [&](uint4 (&v)[16], float (&w)[16]) {
#pragma unroll
    for (int k = 0; k < 4; ++k) {
      v[4 * k] = *reinterpret_cast<const uint4*>(vbase + (long)en[k].x * 128); v[4 * k + 1] = *reinterpret_cast<const uint4*>(vbase + (long)en[k].y * 128);
      v[4 * k + 2] = *reinterpret_cast<const uint4*>(vbase + (long)en[k].z * 128); v[4 * k + 3] = *reinterpret_cast<const uint4*>(vbase + (long)en[k].w * 128);
      w[4 * k] = wn[k].x; w[4 * k + 1] = wn[k].y; w[4 * k + 2] = wn[k].z; w[4 * k + 3] = wn[k].w;
    }
  };
  auto reduce_store = [&](const uint4 (&v)[16], const float (&w)[16], int t) {
    typedef float f2 __attribute__((ext_vector_type(2)));
    f2 acc[8]; float wl = 0.f;
#pragma unroll
    for (int k = 0; k < 8; ++k) acc[k] = f2{0.f, 0.f};
#pragma unroll
    for (int r = 0; r < 16; ++r) {
      wl += w[r];
      const f2 w2 = f2{w[r], w[r]};
      const unsigned vw[4] = {v[r].x, v[r].y, v[r].z, v[r].w};
#pragma unroll
      for (int k = 0; k < 4; ++k) {
        acc[2 * k + 0] = __builtin_elementwise_fma(w2, f2{(float)(vw[k] & 0xffu), (float)((vw[k] >> 8) & 0xffu)}, acc[2 * k + 0]);
        acc[2 * k + 1] = __builtin_elementwise_fma(w2, f2{(float)((vw[k] >> 16) & 0xffu), (float)(vw[k] >> 24)}, acc[2 * k + 1]);
      }
    }
    const float rsum = dpp_row_sum_f(wl);
    const float wsum = (__int_as_float(__builtin_amdgcn_readlane(__float_as_int(rsum), 0)) + __int_as_float(__builtin_amdgcn_readlane(__float_as_int(rsum), 16)) +
                        __int_as_float(__builtin_amdgcn_readlane(__float_as_int(rsum), 32)) + __int_as_float(__builtin_amdgcn_readlane(__float_as_int(rsum), 48))) * 0.125f;
#pragma unroll
    for (int k = 0; k < 4; ++k) *reinterpret_cast<float4*>(red + g8 * 128 + (lane & 7) * 16 + 4 * k) = make_float4(acc[2 * k][0], acc[2 * k][1], acc[2 * k + 1][0], acc[2 * k + 1][1]);
    float2 s = make_float2(0.f, 0.f);
#pragma unroll
    for (int g = 0; g < 8; ++g) { const float2 a = *reinterpret_cast<const float2*>(red + g * 128 + 2 * lane); s.x += a.x; s.y += a.y; }
    h2 zo; zo[0] = (_Float16)(s.x - 128.f * wsum); zo[1] = (_Float16)(s.y - 128.f * wsum);
    *reinterpret_cast<h2*>(Zp + (long)t * 1024 + j * 128 + 2 * lane) = zo;
  };
  auto clampt = [&](int t) { return t < NTOK ? t : wslot; };
  uint4 vA[16], vB[16]; float wA[16], wB[16];
  load_list(wslot); gather(vA, wA);
  load_list(clampt(wslot + nw));
  for (int t = wslot; t < NTOK; t += 2 * nw) {
    gather(vB, wB);
    load_list(clampt(t + 2 * nw));
    reduce_store(vA, wA, t);
    gather(vA, wA);
    load_list(clampt(t + 3 * nw));
    if (t + nw < NTOK) reduce_store(vB, wB, t + nw);
  }
}

DI void phase11c(const Params& P) {
  char* ws = P.ws;
  const _Float16* h1h = (const _Float16*)(ws + OFF_H1H); const _Float16* Zp = (const _Float16*)(ws + OFF_ZP);
  const int wid = VT >> 6, lane = VT & 63;
  float4 gg[4], bb[4];
#pragma unroll
  for (int k = 0; k < 4; ++k) { gg[k] = *reinterpret_cast<const float4*>(P.ln2g + lane * 16 + k * 4); bb[k] = *reinterpret_cast<const float4*>(P.ln2b + lane * 16 + k * 4); }
  const int t0 = VB * 4 + wid, tstep = NVB * 4;
  h8 nx0, nx1, na0, na1;
  {
    const int tt = t0 < NTOK ? t0 : 0;
    nx0 = *reinterpret_cast<const h8*>(h1h + (long)tt * 1024 + lane * 16); nx1 = *reinterpret_cast<const h8*>(h1h + (long)tt * 1024 + lane * 16 + 8);
    na0 = *reinterpret_cast<const h8*>(Zp + (long)tt * 1024 + lane * 16); na1 = *reinterpret_cast<const h8*>(Zp + (long)tt * 1024 + lane * 16 + 8);
  }
  for (int t = t0; t < NTOK; t += tstep) {
    const h8 x0 = nx0, x1 = nx1, a0 = na0, a1 = na1;
    {
      const int tn = t + tstep < NTOK ? t + tstep : t;
      nx0 = *reinterpret_cast<const h8*>(h1h + (long)tn * 1024 + lane * 16); nx1 = *reinterpret_cast<const h8*>(h1h + (long)tn * 1024 + lane * 16 + 8);
      na0 = *reinterpret_cast<const h8*>(Zp + (long)tn * 1024 + lane * 16); na1 = *reinterpret_cast<const h8*>(Zp + (long)tn * 1024 + lane * 16 + 8);
    }
    float z[16]; float s = 0.f;
#pragma unroll
    for (int k = 0; k < 8; ++k) { z[k] = (float)a0[k] + ALPHA * (float)x0[k]; z[8 + k] = (float)a1[k] + ALPHA * (float)x1[k]; }
#pragma unroll
    for (int k = 0; k < 16; ++k) s += z[k];
    const float mu = wave_sum(s) * (1.f / 1024.f);
    float q = 0.f;
#pragma unroll
    for (int k = 0; k < 16; ++k) { const float d = z[k] - mu; q += d * d; }
    const float rstd = rsqrtf(wave_sum(q) * (1.f / 1024.f) + 1e-5f);
#pragma unroll
    for (int k = 0; k < 4; ++k) {
      float4 o;
      o.x = (z[4 * k] - mu) * rstd * gg[k].x + bb[k].x; o.y = (z[4 * k + 1] - mu) * rstd * gg[k].y + bb[k].y;
      o.z = (z[4 * k + 2] - mu) * rstd * gg[k].z + bb[k].z; o.w = (z[4 * k + 3] - mu) * rstd * gg[k].w + bb[k].w;
      *reinterpret_cast<float4*>(P.out + (long)t * 1024 + lane * 16 + k * 4) = o;
    }
  }
}

#define XB_TMO      128
#define XB_XCNT(j)  (256  + 64 * (j))
#define XB_XSUB(j)  (1280 + 64 * (j))
#define XB_XGEN(j)  (2304 + 64 * (j))
#define XB_TOP      3328
#define XB_TOPGEN   3392
#define XCD_BAR_WORDS 3456
#define XB_SPIN_CAP (1u << 18)
#define LAS __attribute__((address_space(3)))

DI unsigned xb_ld(unsigned* p)              { return __hip_atomic_load(p, __ATOMIC_RELAXED, __HIP_MEMORY_SCOPE_AGENT); }
DI unsigned xb_add(unsigned* p, unsigned v) { return __hip_atomic_fetch_add(p, v, __ATOMIC_RELAXED, __HIP_MEMORY_SCOPE_AGENT); }
DI unsigned xb_xcc_id() { return (unsigned)__builtin_amdgcn_s_getreg((3 << 11) | 20) & 0xFu; }
#define XB_SPIN(cond, bar) do { unsigned _sp = 0; while (cond) { __builtin_amdgcn_s_sleep(1); \
    if ((++_sp & 255u) == 0u) { if (xb_ld(&(bar)[XB_TMO])) break; if (_sp > XB_SPIN_CAP) { atomicAdd(&(bar)[XB_TMO], 1u); break; } } } } while (0)

struct XcdBarrier {
    unsigned* bar; unsigned x;
    volatile LAS unsigned* st;
};

DI XcdBarrier xcd_barrier_post(unsigned* bar, volatile LAS unsigned* st) {
    XcdBarrier b; b.bar = bar; b.x = xb_xcc_id(); b.st = st;
    if (threadIdx.x == 0) (void)xb_add(&bar[XB_XCNT(b.x)], 1u);
    return b;
}
DI void xcd_barrier_complete(unsigned* bar, unsigned x, unsigned& nloc, unsigned& nx) {
    const unsigned G = gridDim.x * gridDim.y * gridDim.z;
    unsigned sum, cnt, mine, sp = 0u;
    for (;;) {
        sum = 0u; cnt = 0u; mine = 0u;
#pragma unroll
        for (unsigned j = 0; j < 16; ++j) { const unsigned c = xb_ld(&bar[XB_XCNT(j)]); sum += c; cnt += (c > 0u) ? 1u : 0u; mine = (j == x) ? c : mine; }
        if (sum == G) break;
        __builtin_amdgcn_s_sleep(1);
        if ((++sp & 255u) == 0u) { if (xb_ld(&bar[XB_TMO])) break; if (sp > XB_SPIN_CAP) { atomicAdd(&bar[XB_TMO], 1u); break; } }
    }
    nloc = mine > 0u ? mine : 1u; nx = cnt > 0u ? cnt : 1u;
}

DI void xcd_barrier(const XcdBarrier& b) {
    asm volatile("s_waitcnt vmcnt(0)" ::: "memory");
    __syncthreads();
    if (threadIdx.x == 0) {
        unsigned* bar = b.bar;
        __builtin_amdgcn_s_waitcnt(0);
        unsigned nloc = b.st[0], nx = b.st[1];
        if (nloc == 0u) { xcd_barrier_complete(bar, b.x, nloc, nx); b.st[0] = nloc; b.st[1] = nx; }
        const unsigned old = xb_add(&bar[XB_XSUB(b.x)], 1u);
        const unsigned gen = old / nloc;
        if (old + 1u == (gen + 1u) * nloc) {
            __builtin_amdgcn_fence(__ATOMIC_RELEASE, "agent");
            asm volatile("s_waitcnt vmcnt(0)" ::: "memory");
            const unsigned og = xb_add(&bar[XB_TOP], 1u);
            const unsigned tg = og / nx;
            if (og + 1u == (tg + 1u) * nx) xb_add(&bar[XB_TOPGEN], 1u);
            else XB_SPIN(xb_ld(&bar[XB_TOPGEN]) == tg, bar);
            __builtin_amdgcn_fence(__ATOMIC_ACQUIRE, "agent");
            xb_add(&bar[XB_XGEN(b.x)], 1u);
            asm volatile("s_waitcnt vmcnt(0)" ::: "memory");
        } else {
            XB_SPIN(xb_ld(&bar[XB_XGEN(b.x)]) == gen, bar);
            __builtin_amdgcn_fence(__ATOMIC_ACQUIRE, "agent");
            asm volatile("s_waitcnt vmcnt(0)" ::: "memory");
        }
    }
    __syncthreads();
}


__global__ void __launch_bounds__(512, 1) k_mega(Params P) {
  extern __shared__ __attribute__((aligned(16))) char smem_all[];
  char* smem = smem_all + VHALF * VLDS;
  cg::grid_group grid = cg::this_grid();
  volatile LAS unsigned* xb_st = (volatile LAS unsigned*)(smem_all + 2 * VLDS);
  if (RTID == 0) { xb_st[0] = 0u; xb_st[1] = 0u; xb_st[2] = 0u; xb_st[3] = 0u; }
  __syncthreads();
  const XcdBarrier xb = xcd_barrier_post((unsigned*)(P.ws + OFF_BAR), xb_st);
  if (P.out == nullptr) grid.sync();
  phase0(P, smem); xcd_barrier(xb);
  if (PROBE_DUP == 0) { grid.sync(); phase0(P, smem); grid.sync(); }
  phase1(P, smem_all); xcd_barrier(xb);
  if (PROBE_DUP == 1) { grid.sync(); phase1(P, smem_all); grid.sync(); }
  phase2(P, smem); xcd_barrier(xb);
  if (PROBE_DUP == 2) { grid.sync(); phase2(P, smem); grid.sync(); }
  phase3(P, smem); xcd_barrier(xb);
  if (PROBE_DUP == 3) { grid.sync(); phase3(P, smem); grid.sync(); }
  phase4(P, smem); xcd_barrier(xb);
  if (PROBE_DUP == 4) { grid.sync(); phase4(P, smem); grid.sync(); }
  phase5(P, smem); xcd_barrier(xb);
  if (PROBE_DUP == 5) { grid.sync(); phase5(P, smem); grid.sync(); }
  phase6(P, smem_all); xcd_barrier(xb);
  if (PROBE_DUP == 6) { grid.sync(); phase6(P, smem_all); grid.sync(); }
  phase7(P, smem); xcd_barrier(xb);
  if (PROBE_DUP == 7) { grid.sync(); phase7(P, smem); grid.sync(); }
  phase8(P, smem_all); xcd_barrier(xb);
  if (PROBE_DUP == 8) { grid.sync(); phase8(P, smem_all); grid.sync(); }
  phase9(P, smem); xcd_barrier(xb);
  if (PROBE_DUP == 9) { grid.sync(); phase9(P, smem); grid.sync(); }
  phase10(P, smem); xcd_barrier(xb);
  if (PROBE_DUP == 10) { grid.sync(); phase10(P, smem); grid.sync(); }
  phase11a(P, smem_all); xcd_barrier(xb);
  if (PROBE_DUP == 111) { phase11a(P, smem_all); grid.sync(); }
  phase11b(P, smem_all); xcd_barrier(xb);
  if (PROBE_DUP == 112) { phase11b(P, smem_all); grid.sync(); }
  phase11c(P);
  if (PROBE_DUP == 113) { grid.sync(); phase11c(P); }
}

extern "C" void kernel_launch(void* const* d_in, const int* in_sizes, int n_in, void* d_out, int out_size, void* d_ws, size_t ws_size, hipStream_t stream) {
  if (ws_size < WS_NEED) { fprintf(stderr, "workspace too small: %zu\n", ws_size); return; }
  Params P{};
  P.x = (const float*)d_in[0]; P.w_in = (const float*)d_in[1]; P.a_re = (const float*)d_in[2]; P.a_im = (const float*)d_in[3];
  P.log_dt = (const float*)d_in[4]; P.b_re = (const float*)d_in[5]; P.b_im = (const float*)d_in[6]; P.c_re = (const float*)d_in[7];
  P.c_im = (const float*)d_in[8]; P.dsk = (const float*)d_in[9]; P.w_glu = (const float*)d_in[10]; P.w_out = (const float*)d_in[11];
  P.ln1g = (const float*)d_in[12]; P.ln1b = (const float*)d_in[13]; P.w_q = (const float*)d_in[14]; P.subk = (const float*)d_in[15];
  P.pu = (const float*)d_in[16]; P.pv = (const float*)d_in[17]; P.ln2g = (const float*)d_in[18]; P.ln2b = (const float*)d_in[19];
  P.out = (float*)d_out; P.ws = (char*)d_ws;
  static int grid_blocks = 0;
  if (!grid_blocks) {
    int dev = 0, cus = 0, per_cu = 0;
    hipGetDevice(&dev);
    hipDeviceGetAttribute(&cus, hipDeviceAttributeMultiprocessorCount, dev);
    hipFuncSetAttribute((const void*)k_mega, hipFuncAttributeMaxDynamicSharedMemorySize, LDS_BYTES);
    hipOccupancyMaxActiveBlocksPerMultiprocessor(&per_cu, k_mega, 512, LDS_BYTES);
    if (per_cu > 1) per_cu = 1;
    grid_blocks = (cus * per_cu) & ~7;
  }
  hipMemsetAsync((char*)d_ws + OFF_BAR, 0, XCD_BAR_WORDS * sizeof(unsigned), stream);
  void* args[] = {&P};
  hipError_t e = hipLaunchCooperativeKernel((void*)k_mega, dim3(grid_blocks), dim3(512), args, LDS_BYTES, stream);
  if (e != hipSuccess) fprintf(stderr, "cooperative launch failed: %s (grid %d)\n", hipGetErrorString(e), grid_blocks);
}
```
